# Optimizing an MI355X kernel written in HIP

```python
import jax, jax.numpy as jnp
from jax import lax
import numpy as np

D_MODEL = 1024
BATCH = 16
SEQ = 4096
DEPTH = 4

N_A_LAYERS = DEPTH // 2
N_B_LAYERS = DEPTH - N_A_LAYERS
N_DENSE = (DEPTH + 1) // 2
N_MOE = DEPTH // 2
CONV_WIDTH = 3
ATT_GROUPS = ((128, 1), (512, 4), (2048, 16))
N_GROUPS = len(ATT_GROUPS)
HEAD_DIM = 64
HEADS_PER_GROUP = D_MODEL // 128
ATT_WIDTH = HEADS_PER_GROUP * HEAD_DIM
BLK = 128
D_FF = 11 * D_MODEL // 4
N_EXPERTS = 8
TOP_K = 2
D_EXPERT = 7 * D_MODEL // 2
ALPHA = (2.0 * DEPTH) ** 0.25
BETA = (8.0 * DEPTH) ** -0.25
LN_EPS = 1e-5

kernel_name = "hybrid_shortconv_dilatedattn_moe_deepnorm"


def layer_norm(x, g, b):
    xf = x.astype(jnp.float32)
    mu = jnp.mean(xf, axis=-1, keepdims=True)
    var = jnp.mean(jnp.square(xf - mu), axis=-1, keepdims=True)
    y = (xf - mu) * lax.rsqrt(var + LN_EPS) * g.astype(jnp.float32) + b.astype(jnp.float32)
    return y.astype(x.dtype)


def short_conv_mixer(x, w_in, conv_w, w_out):
    S = x.shape[1]
    gate_b, gate_c, u = jnp.split(jnp.einsum('bsd,dc->bsc', x, w_in), 3, axis=-1)
    u = gate_c * u
    up = jnp.pad(u, ((0, 0), (CONV_WIDTH - 1, 0), (0, 0)))
    conv = sum(conv_w[k] * up[:, k:k + S] for k in range(CONV_WIDTH))
    return jnp.einsum('bsc,cd->bsd', gate_b * conv, w_out)


def swiglu(x, w_gate, w_up, w_down):
    h = jax.nn.silu(jnp.einsum('bsd,df->bsf', x, w_gate)) * jnp.einsum('bsd,df->bsf', x, w_up)
    return jnp.einsum('bsf,fd->bsd', h, w_down)


def moe_swiglu(x, w_router, w_gate, w_up, w_down):
    logits = jnp.einsum('bsd,de->bse', x, w_router, preferred_element_type=jnp.float32)
    top_val, top_idx = lax.top_k(logits, TOP_K)
    gates = jax.nn.softmax(top_val, axis=-1)
    combine = jnp.einsum('bsk,bske->bse', gates,
                         jax.nn.one_hot(top_idx, N_EXPERTS, dtype=jnp.float32)).astype(x.dtype)
    out = jnp.zeros_like(x)
    for e in range(N_EXPERTS):
        out = out + combine[..., e:e + 1] * swiglu(x, w_gate[e], w_up[e], w_down[e])
    return out


def residue_blocks(t, d):
    B, S, H, E = t.shape
    L = -(-S // d)
    nblk = -(-L // BLK)
    Lp = nblk * BLK
    t = jnp.pad(t, ((0, 0), (0, d * Lp - S), (0, 0), (0, 0)))
    t = t.reshape(B, Lp, d, H, E).transpose(0, 2, 1, 3, 4)
    return t.reshape(B, d, nblk, BLK, H, E)


def from_residue_blocks(t, S):
    B, d, nblk, blk = t.shape[:4]
    rest = t.shape[4:]
    t = jnp.moveaxis(t.reshape((B, d, nblk * blk) + rest), 1, 2)
    return t.reshape((B, nblk * blk * d) + rest)[:, :S]


def banded(t):
    prev = jnp.pad(t, ((0, 0), (0, 0), (1, 0), (0, 0), (0, 0), (0, 0)))[:, :, :-1]
    return jnp.concatenate([prev, t], axis=3)


def band_mask(nblk, span):
    q = jnp.arange(BLK)[:, None]
    k = jnp.arange(2 * BLK)[None, :]
    dist = BLK + q - k
    n = jnp.arange(nblk)[:, None, None]
    return (dist >= 0) & (dist <= span) & ((n > 0) | (k >= BLK))


def shared_kv(x, kv_w):
    B, S, _ = x.shape
    kv = jnp.einsum('bsd,dc->bsc', x, kv_w).reshape(B, S, N_GROUPS, 2, HEADS_PER_GROUP, HEAD_DIM)
    blocks = []
    for g, (window, d) in enumerate(ATT_GROUPS):
        blocks.append((residue_blocks(kv[:, :, g, 0], d), residue_blocks(kv[:, :, g, 1], d)))
    return tuple(blocks)


def dilated_group_attention(q, k_res, v_res, d, span):
    S = q.shape[1]
    qb = residue_blocks(q, d)
    kb = banded(k_res)
    vb = banded(v_res)
    nblk = qb.shape[2]
    s = jnp.einsum('bdnqhe,bdnkhe->bdnhqk', qb, kb,
                   preferred_element_type=jnp.float32) * (HEAD_DIM ** -0.5)
    s = jnp.where(band_mask(nblk, span)[None, None, :, None], s, -jnp.inf)
    lse = jax.nn.logsumexp(s, axis=-1)
    p = jnp.exp(s - lse[..., None])
    o = jnp.einsum('bdnhqk,bdnkhe->bdnqhe', p.astype(vb.dtype), vb,
                   preferred_element_type=jnp.float32)
    o = from_residue_blocks(o, S)
    lse = from_residue_blocks(jnp.moveaxis(lse, 3, 4), S)
    return o, lse


def dilated_mixer(x, w_q, w_o, kv_blocks):
    B, S, _ = x.shape
    q = jnp.einsum('bsd,dc->bsc', x, w_q).reshape(B, S, N_GROUPS, HEADS_PER_GROUP, HEAD_DIM)
    outs, lses = [], []
    for g, (window, d) in enumerate(ATT_GROUPS):
        k_res, v_res = kv_blocks[g]
        o, lse = dilated_group_attention(q[:, :, g], k_res, v_res, d, window // d)
        outs.append(o)
        lses.append(lse)
    w = jax.nn.softmax(jnp.stack(lses, axis=-1), axis=-1)
    o = jnp.einsum('bshg,bshge->bshe', w, jnp.stack(outs, axis=3))
    o = o.reshape(B, S, ATT_WIDTH).astype(x.dtype)
    return jnp.einsum('bsc,cd->bsd', o, w_o)


def setup_inputs(seed: int = 0) -> dict:
    key = jax.random.key(seed)
    ks = jax.random.split(key, 16)
    D = D_MODEL

    def nrm(k, shape, fan_in, scale=1.0):
        return jax.random.normal(k, shape, jnp.float32) * (scale * fan_in ** -0.5)

    return {
        'x': jax.random.normal(ks[0], (BATCH, SEQ, D), jnp.float32),
        'a_w_in': nrm(ks[1], (N_A_LAYERS, D, 3 * D), D),
        'a_conv': nrm(ks[2], (N_A_LAYERS, CONV_WIDTH, D), CONV_WIDTH),
        'a_w_out': nrm(ks[3], (N_A_LAYERS, D, D), D, BETA),
        'kv_w': nrm(ks[4], (D, N_GROUPS * 2 * ATT_WIDTH), D),
        'b_w_q': nrm(ks[5], (N_B_LAYERS, D, N_GROUPS * ATT_WIDTH), D),
        'b_w_o': nrm(ks[6], (N_B_LAYERS, ATT_WIDTH, D), ATT_WIDTH, BETA),
        'ffn_w_gate': nrm(ks[7], (N_DENSE, D, D_FF), D),
        'ffn_w_up': nrm(ks[8], (N_DENSE, D, D_FF), D),
        'ffn_w_down': nrm(ks[9], (N_DENSE, D_FF, D), D_FF, BETA),
        'moe_w_router': nrm(ks[10], (N_MOE, D, N_EXPERTS), D),
        'moe_w_gate': nrm(ks[11], (N_MOE, N_EXPERTS, D, D_EXPERT), D),
        'moe_w_up': nrm(ks[12], (N_MOE, N_EXPERTS, D, D_EXPERT), D),
        'moe_w_down': nrm(ks[13], (N_MOE, N_EXPERTS, D_EXPERT, D), D_EXPERT, BETA),
        'ln_g': 1.0 + 0.02 * jax.random.normal(ks[14], (DEPTH, 2, D), jnp.float32),
        'ln_b': 0.02 * jax.random.normal(ks[15], (DEPTH, 2, D), jnp.float32),
    }


def reference(x, a_w_in, a_conv, a_w_out, kv_w, b_w_q, b_w_o, ffn_w_gate, ffn_w_up, ffn_w_down,
              moe_w_router, moe_w_gate, moe_w_up, moe_w_down, ln_g, ln_b):
    kv_blocks = None
    for l in range(DEPTH):
        if l < N_A_LAYERS:
            mix = short_conv_mixer(x, a_w_in[l], a_conv[l], a_w_out[l])
        else:
            if kv_blocks is None:
                kv_blocks = shared_kv(x, kv_w)
            j = l - N_A_LAYERS
            mix = dilated_mixer(x, b_w_q[j], b_w_o[j], kv_blocks)
        x = layer_norm(ALPHA * x + mix, ln_g[l, 0], ln_b[l, 0])
        i = l // 2
        if l % 2 == 0:
            ff = swiglu(x, ffn_w_gate[i], ffn_w_up[i], ffn_w_down[i])
        else:
            ff = moe_swiglu(x, moe_w_router[i], moe_w_gate[i], moe_w_up[i], moe_w_down[i])
        x = layer_norm(ALPHA * x + ff, ln_g[l, 1], ln_b[l, 1])
    return x
```

```cpp
#include <hip/hip_runtime.h>
#include <cstdio>
#include <cstdint>

#ifndef MK_DEBUG
#define MK_DEBUG 0
#endif

namespace mk {
#define LAS __attribute__((address_space(3)))
typedef unsigned short bf16_t;
typedef short bf16x8 __attribute__((ext_vector_type(8)));
typedef short bf16x4 __attribute__((ext_vector_type(4)));
typedef float f32x4 __attribute__((ext_vector_type(4)));
typedef unsigned u32x4 __attribute__((ext_vector_type(4)));
typedef unsigned u32x2 __attribute__((ext_vector_type(2)));

constexpr int NB = 16, SEQ = 4096, D = 1024, M = NB * SEQ;
constexpr int DFF = 2816, NE = 8, DEX = 3584, ATTW = 512, NQ = 3 * ATTW, NKV = 6 * ATTW;
constexpr float ALPHA = 1.6817928305074292f;
constexpr float LN_EPS = 1e-5f;
constexpr int NWG = 256, NTHR = 512;
constexpr int NSLOT = 2 * M;
constexpr int CH_TILES = 128, NCHUNK = 4, CH_LAST = 136, TILE_CAP = 640;

constexpr size_t MiB = (size_t)1 << 20;
constexpr size_t WS_CTL = 0;
constexpr size_t CTL_ZERO_BYTES = 64 * 1024;
constexpr int CW_BAR = 1024;
constexpr int CW_DBG = 8192;
constexpr size_t CTL_CNT = 64 * 1024;
constexpr size_t CTL_TAB = 80 * 1024;
constexpr size_t CTL_META = 96 * 1024;
constexpr size_t WS_SMALL = 1 * MiB;
constexpr size_t WS_WIN = WS_SMALL, WS_WOUT = WS_SMALL + 12 * MiB, WS_WQKV2 = WS_SMALL + 16 * MiB, WS_WQ3 = WS_SMALL + 25 * MiB, WS_WO = WS_SMALL + 28 * MiB,
                 WS_WGU = WS_SMALL + 30 * MiB, WS_WDN = WS_SMALL + 52 * MiB;
constexpr size_t SZ_WIN = (size_t)3 * D * D * 2, SZ_WOUT = (size_t)D * D * 2, SZ_WO = (size_t)D * ATTW * 2, SZ_WGU = (size_t)2 * DFF * D * 2, SZ_WDN = (size_t)D * DFF * 2;
constexpr size_t WS_WM = 65 * MiB;
constexpr size_t SZ_WMGU = (size_t)NE * 2 * DEX * D * 2;
constexpr size_t WS_XA = 233 * MiB;
constexpr size_t WS_ROUTE = 361 * MiB;
constexpr size_t RT_TOKE = 0, RT_TOKG = 512 * 1024, RT_TOKR = 1024 * 1024, RT_SLOTT = 1536 * 1024, RT_SLOTG = 2048 * 1024 + 4096, RT_TOKS = 2560 * 1024 + 8192;
constexpr size_t WS_BIG = 365 * MiB;
constexpr size_t BG_CU = 0, BG_GB = 128 * MiB, BG_G = 256 * MiB;
constexpr size_t BG_K = 0, BG_V = 192 * MiB  , BG_OG = 384 * MiB, BG_LSE = 576 * MiB, BG_YATT = 384 * MiB;
constexpr size_t BG_HH = 384 * MiB;
constexpr size_t BG_HC = 0, BG_Y2 = 238 * MiB;
constexpr size_t WS_NEED = WS_BIG + 640 * MiB;
constexpr size_t DO_Q = 0, DO_O = 192 * MiB;

typedef float f32x2c __attribute__((ext_vector_type(2)));
typedef __bf16 bf16x2c __attribute__((ext_vector_type(2)));
__device__ __forceinline__ unsigned cvt_pk_bf16(float lo, float hi) { const f32x2c v = {lo, hi}; return __builtin_bit_cast(unsigned, __builtin_convertvector(v, bf16x2c)); }
__device__ __forceinline__ float bf_lo(unsigned w) { return __uint_as_float(w << 16); }
__device__ __forceinline__ float bf_hi(unsigned w) { return __uint_as_float(w & 0xffff0000u); }
__device__ __forceinline__ int ld_agent(const int* p) { return __hip_atomic_load(p, __ATOMIC_RELAXED, __HIP_MEMORY_SCOPE_AGENT); }
__device__ __forceinline__ int opaque_tid() { int t = threadIdx.x; asm volatile("" : "+v"(t)); return t; }
__device__ __forceinline__ int opq_i(int v) { asm volatile("" : "+s"(v)); return v; }
template <class T> __device__ __forceinline__ T* opq(T* p) { asm volatile("" : "+s"(p)); return p; }
__device__ __forceinline__ float wave_sum(float v) {
    v += __builtin_bit_cast(float, __builtin_amdgcn_update_dpp(0, __builtin_bit_cast(int, v), 0xB1, 0xf, 0xf, true));
    v += __builtin_bit_cast(float, __builtin_amdgcn_update_dpp(0, __builtin_bit_cast(int, v), 0x4E, 0xf, 0xf, true));
    v += __builtin_bit_cast(float, __builtin_amdgcn_update_dpp(0, __builtin_bit_cast(int, v), 0x141, 0xf, 0xf, true));
    v += __builtin_bit_cast(float, __builtin_amdgcn_update_dpp(0, __builtin_bit_cast(int, v), 0x140, 0xf, 0xf, true));
    v += __builtin_bit_cast(float, __builtin_amdgcn_update_dpp(0, __builtin_bit_cast(int, v), 0x142, 0xa, 0xf, false));
    v += __builtin_bit_cast(float, __builtin_amdgcn_update_dpp(0, __builtin_bit_cast(int, v), 0x143, 0xc, 0xf, false));
    return __builtin_bit_cast(float, __builtin_amdgcn_readlane(__builtin_bit_cast(int, v), 63));
}
__device__ __forceinline__ float shx(float v, int o, int lane) { return __builtin_bit_cast(float, __builtin_amdgcn_ds_bpermute((lane ^ o) << 2, __builtin_bit_cast(int, v))); }

#define XB_TMO      128
#define XB_XCNT(j)  (256  + 64 * (j))
#define XB_XSUB(j)  (1280 + 64 * (j))
#define XB_XGEN(j)  (2304 + 64 * (j))
#define XB_TOP      3328
#define XB_TOPGEN   3392
#define XCD_BAR_WORDS 3456
#define XB_SPIN_CAP (1u << 18)
__device__ __forceinline__ unsigned xb_ld(unsigned* p)              { return __hip_atomic_load(p, __ATOMIC_RELAXED, __HIP_MEMORY_SCOPE_AGENT); }
__device__ __forceinline__ unsigned xb_add(unsigned* p, unsigned v) { return __hip_atomic_fetch_add(p, v, __ATOMIC_RELAXED, __HIP_MEMORY_SCOPE_AGENT); }
__device__ __forceinline__ unsigned xb_xcc_id() { return (unsigned)__builtin_amdgcn_s_getreg((3 << 11) | 20) & 0xFu; }
#define XB_SPIN(cond, bar) do { unsigned _sp = 0; while (cond) { __builtin_amdgcn_s_sleep(1); \
    if ((++_sp & 255u) == 0u) { if (xb_ld(&(bar)[XB_TMO])) break; if (_sp > XB_SPIN_CAP) { atomicAdd(&(bar)[XB_TMO], 1u); break; } } } } while (0)
struct XcdBarrier { unsigned* bar; unsigned x; volatile LAS unsigned* st; };
__device__ __forceinline__ XcdBarrier xcd_barrier_post(unsigned* bar, volatile LAS unsigned* st) {
    XcdBarrier b; b.bar = bar; b.x = xb_xcc_id(); b.st = st;
    if (threadIdx.x == 0) (void)xb_add(&bar[XB_XCNT(b.x)], 1u);
    return b;
}
__device__ __forceinline__ void xcd_barrier_complete(unsigned* bar, unsigned x, unsigned& nloc, unsigned& nx) {
    const unsigned G = gridDim.x * gridDim.y * gridDim.z;
    unsigned sum, cnt, mine, sp = 0u;
    for (;;) {
        sum = 0u; cnt = 0u; mine = 0u;
#pragma unroll
        for (unsigned j = 0; j < 16; ++j) { const unsigned c = xb_ld(&bar[XB_XCNT(j)]); sum += c; cnt += (c > 0u) ? 1u : 0u; mine = (j == x) ? c : mine; }
        if (sum == G) break;
        __builtin_amdgcn_s_sleep(1);
        if ((++sp & 255u) == 0u) { if (xb_ld(&bar[XB_TMO])) break; if (sp > XB_SPIN_CAP) { atomicAdd(&bar[XB_TMO], 1u); break; } }
    }
    nloc = mine > 0u ? mine : 1u; nx = cnt > 0u ? cnt : 1u;
}
__device__ __forceinline__ void xcd_barrier(const XcdBarrier& b) {
    asm volatile("s_waitcnt vmcnt(0)" ::: "memory");
    __syncthreads();
    if (threadIdx.x == 0) {
        unsigned* bar = b.bar;
        __builtin_amdgcn_s_waitcnt(0);
        unsigned nloc = b.st[0], nx = b.st[1];
        if (nloc == 0u) { xcd_barrier_complete(bar, b.x, nloc, nx); b.st[0] = nloc; b.st[1] = nx; }
        const unsigned old = xb_add(&bar[XB_XSUB(b.x)], 1u);
        const unsigned gen = old / nloc;
        if (old + 1u == (gen + 1u) * nloc) {
            __builtin_amdgcn_fence(__ATOMIC_RELEASE, "agent");
            asm volatile("s_waitcnt vmcnt(0)" ::: "memory");
            const unsigned og = xb_add(&bar[XB_TOP], 1u);
            const unsigned tg = og / nx;
            if (og + 1u == (tg + 1u) * nx) xb_add(&bar[XB_TOPGEN], 1u);
            else XB_SPIN(xb_ld(&bar[XB_TOPGEN]) == tg, bar);
            __builtin_amdgcn_fence(__ATOMIC_ACQUIRE, "agent");
            xb_add(&bar[XB_XGEN(b.x)], 1u);
            asm volatile("s_waitcnt vmcnt(0)" ::: "memory");
        } else {
            XB_SPIN(xb_ld(&bar[XB_XGEN(b.x)]) == gen, bar);
            __builtin_amdgcn_fence(__ATOMIC_ACQUIRE, "agent");
            asm volatile("s_waitcnt vmcnt(0)" ::: "memory");
        }
    }
    __syncthreads();
}

#ifndef MOE_WGM
#define MOE_WGM 8
#endif
constexpr int BM = 256, BK = 64, HALF = 128, HTB = HALF * BK * 2, STAGE_BYTES = 8 * HTB, NXCD = 8, WGM = 4;
__device__ __forceinline__ int lds_byte(int r, int c) { const int st = (r >> 4) * 2 + (c >> 5), rr = r & 15, cc = c & 31, ob = rr * 64 + cc * 2; return st * 1024 + (ob ^ (((ob >> 9) & 1) << 5)); }
__device__ __forceinline__ void stage_rc(int b, int& R, int& C) { const int st = b / 1024, sb = b % 1024, swz = sb ^ (((sb >> 9) & 1) << 5); R = (st >> 1) * 16 + swz / 64; C = (st & 1) * 32 + (swz % 64) / 2; }
__device__ __forceinline__ int perm32(int rho) { const int n = rho >> 4, i = rho & 15; return 8 * (i >> 2) + 4 * n + (i & 3); }

struct Unit { int arow, brow, orow, pn, lo, hi; };
struct Gemm { const bf16_t* A; const bf16_t* Bt; int K; };

struct DenseOrder {
    int nM, nN, nwg, G, c, row_base;
    __device__ __forceinline__ void init(int Mrows, int N, int G_, int c_, int row_base_) { nM = Mrows / BM; nN = N / BM; nwg = nM * nN; G = G_; c = c_; row_base = row_base_; }
    __device__ __forceinline__ bool next(int i, Unit& u) const {
        const long L = (long)i * G + c; if (L >= nwg) return false;
        int wgid = (int)L; { const int q = nwg / NXCD, r = nwg % NXCD, xcd = wgid % NXCD, off = wgid / NXCD; wgid = (xcd < r ? xcd * (q + 1) : r * (q + 1) + (xcd - r) * q) + off; }
        const int nig = WGM * nN, gid = wgid / nig, fm = gid * WGM, gsz = (nM - fm) < WGM ? (nM - fm) : WGM;
        const int pm = fm + ((wgid % nig) % gsz), pn = (wgid % nig) / gsz;
        u.arow = pm * BM; u.brow = pn * BM; u.orow = row_base + pm * BM; u.pn = pn; u.lo = 0; u.hi = BM; return true;
    }
};
struct MoeOrder {
    const LAS int* tab; int nt, nN, G, c, row0c, brows, down;
    __device__ __forceinline__ bool next(int i, Unit& u) const {
        constexpr int MG = 8; const int per = MG * nN / (G / NXCD);
        const int nsr = nt / (MG * NXCD), ifull = nsr * per; int tl, pn;
        if (i < ifull) { const int j = i * (G / NXCD) + c / NXCD, a = j / (MG * nN), w = j % (MG * nN); tl = (a * NXCD + c % NXCD) * MG + w % MG; pn = w / MG; }
        else { const int ntr = nt - nsr * MG * NXCD, L0 = (i - ifull) * G + c, nwg = ntr * nN; if (L0 >= nwg) return false;
            int L = L0; { const int q = nwg / NXCD, r = nwg % NXCD, xcd = L % NXCD, off = L / NXCD; L = (xcd < r ? xcd * (q + 1) : r * (q + 1) + (xcd - r) * q) + off; }
            const int nig = MG * nN, gid = L / nig, fm = gid * MG, gsz = (ntr - fm) < MG ? (ntr - fm) : MG, w = L % nig;
            tl = nsr * MG * NXCD + fm + w % gsz; pn = w / gsz; }
        const LAS int* tt = tab + 4 * tl;
        const int e = __builtin_amdgcn_readfirstlane(tt[0]), row0 = __builtin_amdgcn_readfirstlane(tt[1]);
        u.lo = __builtin_amdgcn_readfirstlane(tt[2]); u.hi = __builtin_amdgcn_readfirstlane(tt[3]);
        u.pn = pn; u.brow = e * brows + pn * BM;
        if (!down) { u.arow = row0; u.orow = row0 - row0c; } else { u.arow = row0 - row0c; u.orow = row0; }
        return true;
    }
};

#define EPI_ROWS(ai, m) ((ai) * HALF + wr * 64 + (m) * 16 + fr)
__device__ __forceinline__ u32x4 pack8(const f32x4& a, const f32x4& b) { u32x4 w; w.x = cvt_pk_bf16(a[0], a[1]); w.y = cvt_pk_bf16(a[2], a[3]); w.z = cvt_pk_bf16(b[0], b[1]); w.w = cvt_pk_bf16(b[2], b[3]); return w; }
__device__ __forceinline__ float silu(float x) { return x * __builtin_amdgcn_rcpf(1.0f + __builtin_amdgcn_exp2f(-1.4426950408889634f * x)); }

struct EpiResid {
    bf16_t* Y; const bf16_t* X;
    __device__ __forceinline__ void operator()(const f32x4 (&acc)[2][2][4][2], const Unit& u, int wr, int wc, int fr, int fq) const {
        const int col0 = u.pn * BM + wc * 32 + 8 * fq;
#pragma unroll
        for (int ai = 0; ai < 2; ++ai)
#pragma unroll
            for (int m = 0; m < 4; ++m) { const size_t off = (size_t)(u.orow + EPI_ROWS(ai, m)) * D + col0;
#pragma unroll
                for (int bj = 0; bj < 2; ++bj) { const u32x4 xv = *(const u32x4*)(X + off + bj * HALF); const f32x4 a0 = acc[ai][bj][m][0], a1 = acc[ai][bj][m][1];
                    f32x4 o0, o1; o0[0] = ALPHA * bf_lo(xv.x) + a0[0]; o0[1] = ALPHA * bf_hi(xv.x) + a0[1]; o0[2] = ALPHA * bf_lo(xv.y) + a0[2]; o0[3] = ALPHA * bf_hi(xv.y) + a0[3];
                    o1[0] = ALPHA * bf_lo(xv.z) + a1[0]; o1[1] = ALPHA * bf_hi(xv.z) + a1[1]; o1[2] = ALPHA * bf_lo(xv.w) + a1[2]; o1[3] = ALPHA * bf_hi(xv.w) + a1[3];
                    *(u32x4*)(Y + off + bj * HALF) = pack8(o0, o1); }
                asm volatile("" ::: "memory"); }
    }
};
struct EpiSwiGLU {
    bf16_t* H; int ldh;
    __device__ __forceinline__ void operator()(const f32x4 (&acc)[2][2][4][2], const Unit& u, int wr, int wc, int fr, int fq) const {
        const int col0 = u.pn * HALF + wc * 32 + 8 * fq;
#pragma unroll
        for (int ai = 0; ai < 2; ++ai)
#pragma unroll
            for (int m = 0; m < 4; ++m) { const int r = EPI_ROWS(ai, m);
                if (r >= u.lo && r < u.hi) { f32x4 h0, h1;
#pragma unroll
                    for (int j = 0; j < 4; ++j) { h0[j] = silu(acc[ai][0][m][0][j]) * acc[ai][1][m][0][j]; h1[j] = silu(acc[ai][0][m][1][j]) * acc[ai][1][m][1][j]; }
                    *(u32x4*)(H + (size_t)(u.orow + r) * ldh + col0) = pack8(h0, h1); } }
    }
};
struct EpiCU {
    bf16_t* CU; bf16_t* GB;
    __device__ __forceinline__ void operator()(const f32x4 (&acc)[2][2][4][2], const Unit& u, int wr, int wc, int fr, int fq) const {
        if (u.pn < 8) { const int col0 = u.pn * HALF + wc * 32 + 8 * fq;
#pragma unroll
            for (int ai = 0; ai < 2; ++ai)
#pragma unroll
                for (int m = 0; m < 4; ++m) { const f32x4 c0 = acc[ai][0][m][0] * acc[ai][1][m][0], c1 = acc[ai][0][m][1] * acc[ai][1][m][1];
                    *(u32x4*)(CU + (size_t)(u.orow + EPI_ROWS(ai, m)) * D + col0) = pack8(c0, c1); }
        } else { const int col0 = (u.pn - 8) * BM + wc * 32 + 8 * fq;
#pragma unroll
            for (int ai = 0; ai < 2; ++ai)
#pragma unroll
                for (int m = 0; m < 4; ++m)
#pragma unroll
                    for (int bj = 0; bj < 2; ++bj) *(u32x4*)(GB + (size_t)(u.orow + EPI_ROWS(ai, m)) * D + col0 + bj * HALF) = pack8(acc[ai][bj][m][0], acc[ai][bj][m][1]);
        }
    }
};
__device__ __forceinline__ size_t resid_off(int token, int g, int h, int e) {
    const int b = token >> 12, s = token & 4095, sh = 2 * g, rr = s & ((1 << sh) - 1), i = s >> sh, L = 4096 >> sh;
    return ((size_t)((b * 3 + g) * 8 + h) * 4096 + (size_t)rr * L + i) * 64 + e;
}
struct EpiQKV {
    bf16_t *Q, *KV;
    __device__ __forceinline__ void operator()(const f32x4 (&acc)[2][2][4][2], const Unit& u, int wr, int wc, int fr, int fq) const {
#pragma unroll
        for (int bj = 0; bj < 2; ++bj) { const int cw = u.pn * BM + bj * HALF + wc * 32;
            const bool isq = cw < NQ; const int c2 = cw - NQ;
            const int g = isq ? (cw >> 9) : (c2 >> 10), h = isq ? ((cw >> 6) & 7) : ((c2 >> 6) & 7);
            bf16_t* dst = KV + (size_t)((c2 >> 9) & 1) * ((size_t)M * 1536); if (isq) dst = Q;
            const int e0 = (cw & 63) + 8 * fq, sh = 2 * g, L = 4096 >> sh;
#pragma unroll
            for (int ai = 0; ai < 2; ++ai)
#pragma unroll
                for (int m = 0; m < 4; ++m) { const int token = u.orow + EPI_ROWS(ai, m), b = token >> 12, s = token & 4095, rr = s & ((1 << sh) - 1), i = s >> sh;
                    *(u32x4*)(dst + ((size_t)((b * 3 + g) * 8 + h) * 4096 + (size_t)(rr * L + i)) * 64 + e0) = pack8(acc[ai][bj][m][0], acc[ai][bj][m][1]);
                    asm volatile("" ::: "memory"); }
        }
    }
};
struct EpiMoeDown {
    bf16_t* Y2; const int* slot_tok; const float* slot_gate;
    __device__ __forceinline__ void operator()(const f32x4 (&acc)[2][2][4][2], const Unit& u, int wr, int wc, int fr, int fq) const {
        const int col0 = u.pn * BM + wc * 32 + 8 * fq;
#pragma unroll
        for (int ai = 0; ai < 2; ++ai)
#pragma unroll
            for (int m = 0; m < 4; ++m) { const int r = EPI_ROWS(ai, m);
                if (r >= u.lo && r < u.hi) { const int ent = slot_tok[u.orow + r]; const float gt = slot_gate[u.orow + r];
                    bf16_t* rowp = Y2 + ((size_t)(ent & 1) * M + (ent >> 1)) * D + col0;
#pragma unroll
                    for (int bj = 0; bj < 2; ++bj) *(u32x4*)(rowp + bj * HALF) = pack8(acc[ai][bj][m][0] * gt, acc[ai][bj][m][1] * gt); } }
    }
};

__device__ __forceinline__ int moe_tab_to_lds(const int* gtab, int t0, int nt, LAS int* ltab) {
    const int tid = opaque_tid();
    for (int i = tid; i < 4 * nt; i += NTHR) ltab[i] = ld_agent(gtab + 4 * t0 + i);
    const int row0c = __builtin_amdgcn_readfirstlane(ld_agent(gtab + 4 * t0 + 1));
    __syncthreads();
    return row0c;
}
template <class Epi, class Sched>
__device__ __forceinline__ void gemm_phase(LAS unsigned char* lds, const Gemm g, const Sched& S, const Epi& E) {
    const int tid = opaque_tid(), wid = __builtin_amdgcn_readfirstlane(tid >> 6), lane = tid & 63, wr = wid >> 2, wc = wid & 3, fr = lane & 15, fq = lane >> 4;
    const int K = g.K, nt = K / BK;
    unsigned voffA[2], voffB[2];
#pragma unroll
    for (int i = 0; i < 2; ++i) { const int R = wid * 8 + i * 64 + (lane >> 3), C = 8 * ((lane & 7) ^ ((R >> 1) & 7)); const int Rb = (R & ~31) + perm32(R & 31);
        voffA[i] = (unsigned)(R * K + C) * 2u; voffB[i] = (unsigned)(Rb * K + C) * 2u; }
    const size_t kstep = (size_t)(BK * 2);
    const size_t hstep = (size_t)HALF * K * 2;
    const size_t rstep = (size_t)K * 2;
    const unsigned ldsw = (unsigned)wid * 1024u;
    int aoffk[2], boffk[2];
#pragma unroll
    for (int k = 0; k < 2; ++k) { const int ch = ((4 * k + fq) ^ ((fr >> 1) & 7)) << 4; aoffk[k] = (wr * 64 + fr) * 128 + ch; boffk[k] = (wc * 32 + fr) * 128 + ch; }
#define PG8_SA(b, h) (((b) * 2 + (h)) * HTB)
#define PG8_SB(b, h) ((4 + (b) * 2 + (h)) * HTB)
#define PG8_STAGE(bufoff, gbase, voff) do { _Pragma("unroll") for (int _i = 0; _i < 2; ++_i) \
        __builtin_amdgcn_global_load_lds((const unsigned*)((const char*)(gbase) + (voff)[_i]), (LAS unsigned*)(lds + (bufoff) + ldsw + _i * 8192), 16, 0, 0); } while (0)
#define PG8_LDA(dst, b, h) do { _Pragma("unroll") for (int m = 0; m < 4; ++m) _Pragma("unroll") for (int k = 0; k < 2; ++k) dst[m][k] = *(const LAS bf16x8*)(lds + PG8_SA(b, h) + aoffk[k] + m * 2048); } while (0)
#define PG8_LDB(dst, b, h) do { _Pragma("unroll") for (int n = 0; n < 2; ++n) _Pragma("unroll") for (int k = 0; k < 2; ++k) dst[n][k] = *(const LAS bf16x8*)(lds + PG8_SB(b, h) + boffk[k] + n * 2048); } while (0)
#define PG8_MMA(ai, bj, At, Bt) do { __builtin_amdgcn_s_setprio(1); _Pragma("unroll") for (int m = 0; m < 4; ++m) _Pragma("unroll") for (int n = 0; n < 2; ++n) _Pragma("unroll") for (int k = 0; k < 2; ++k) \
        acc[ai][bj][m][n] = __builtin_amdgcn_mfma_f32_16x16x32_bf16(Bt[n][k], At[m][k], acc[ai][bj][m][n], 0, 0, 0); __builtin_amdgcn_s_setprio(0); } while (0)
#define PG8_WAIT_V(n) asm volatile("s_waitcnt vmcnt(" #n ")" ::: "memory")
#define PG8_WAIT_L(n) asm volatile("s_waitcnt lgkmcnt(" #n ")" ::: "memory")
#define PG8_BAR __builtin_amdgcn_s_barrier()
#define PG8_SCHED __builtin_amdgcn_sched_barrier(0)
    Unit cur, nxt; int ui = 0;
    if (!S.next(0, cur)) return;
    f32x4 acc[2][2][4][2];
#pragma unroll
    for (int a = 0; a < 2; ++a)
#pragma unroll
        for (int b = 0; b < 2; ++b)
#pragma unroll
            for (int m = 0; m < 4; ++m)
#pragma unroll
                for (int n = 0; n < 2; ++n) acc[a][b][m][n] = (f32x4){0.f, 0.f, 0.f, 0.f};
    bf16x8 At[4][2], B0[2][2], B1[2][2];
    const char* cA = (const char*)g.A + (size_t)cur.arow * rstep; const char* cB = (const char*)g.Bt + (size_t)cur.brow * rstep;
    PG8_STAGE(PG8_SB(0, 0), cB, voffB); PG8_STAGE(PG8_SB(0, 1), cB + hstep, voffB); PG8_STAGE(PG8_SA(0, 0), cA, voffA); PG8_STAGE(PG8_SA(0, 1), cA + hstep, voffA);
    if (wr == 1) PG8_BAR;
    PG8_WAIT_V(2); PG8_BAR;
    PG8_STAGE(PG8_SB(1, 0), cB + kstep, voffB); PG8_STAGE(PG8_SA(1, 0), cA + kstep, voffA); PG8_STAGE(PG8_SB(1, 1), cB + hstep + kstep, voffB);
    PG8_WAIT_V(6); PG8_BAR;
    for (;;) {
        const bool has_next = S.next(ui + 1, nxt);
        const char* nA = has_next ? (const char*)g.A + (size_t)nxt.arow * rstep : cA; const char* nB = has_next ? (const char*)g.Bt + (size_t)nxt.brow * rstep : cB;
        for (int t = 0; t < nt; t += 2) {
            const bool last = (t == nt - 2);
            const char* a1 = cA + (size_t)(t + 1) * kstep;
            const char* a2 = last ? nA : cA + (size_t)(t + 2) * kstep; const char* b2 = last ? nB : cB + (size_t)(t + 2) * kstep;
            const char* a3 = a2 + kstep; const char* b3 = b2 + kstep;
            PG8_LDB(B0, 0, 0); PG8_LDB(B1, 0, 1); PG8_SCHED; PG8_LDA(At, 0, 0); PG8_STAGE(PG8_SA(1, 1), a1 + hstep, voffA);
            PG8_WAIT_V(8); PG8_WAIT_L(0); PG8_BAR; PG8_MMA(0, 0, At, B0); PG8_MMA(0, 1, At, B1); PG8_BAR; PG8_SCHED;
            PG8_LDA(At, 0, 1); PG8_STAGE(PG8_SB(0, 0), b2, voffB); PG8_STAGE(PG8_SB(0, 1), b2 + hstep, voffB); PG8_STAGE(PG8_SA(0, 0), a2, voffA);
            PG8_WAIT_V(8); PG8_WAIT_L(0); PG8_BAR; PG8_MMA(1, 0, At, B0); PG8_MMA(1, 1, At, B1); PG8_BAR; PG8_SCHED;
            PG8_LDB(B0, 1, 0); PG8_LDB(B1, 1, 1); PG8_SCHED; PG8_LDA(At, 1, 0); PG8_STAGE(PG8_SA(0, 1), a2 + hstep, voffA);
            PG8_WAIT_V(8); PG8_WAIT_L(0); PG8_BAR; PG8_MMA(0, 0, At, B0); PG8_MMA(0, 1, At, B1); PG8_BAR; PG8_SCHED;
            PG8_LDA(At, 1, 1); PG8_STAGE(PG8_SB(1, 0), b3, voffB); PG8_STAGE(PG8_SB(1, 1), b3 + hstep, voffB); PG8_STAGE(PG8_SA(1, 0), a3, voffA);
            PG8_WAIT_V(8); PG8_WAIT_L(0); PG8_BAR; PG8_MMA(1, 0, At, B0); PG8_MMA(1, 1, At, B1); PG8_BAR; PG8_SCHED;
        }
        if (wr == 0) PG8_BAR;
        E(acc, cur, wr, wc, fr, fq);
        if (!has_next) break;
#pragma unroll
        for (int a = 0; a < 2; ++a)
#pragma unroll
            for (int b = 0; b < 2; ++b)
#pragma unroll
                for (int m = 0; m < 4; ++m)
#pragma unroll
                    for (int n = 0; n < 2; ++n) acc[a][b][m][n] = (f32x4){0.f, 0.f, 0.f, 0.f};
        cur = nxt; cA = nA; cB = nB; ++ui;
        if (wr == 1) PG8_BAR;
    }
    PG8_WAIT_V(0);
    PG8_BAR;
#undef PG8_SA
#undef PG8_SB
#undef PG8_STAGE
#undef PG8_LDA
#undef PG8_LDB
#undef PG8_MMA
#undef PG8_WAIT_V
#undef PG8_WAIT_L
#undef PG8_BAR
#undef PG8_SCHED
}

constexpr int LDS_MISC = 139264;
constexpr int LDS_BYTES = 147456;
constexpr int LDS_TAB = LDS_MISC + 64;
static_assert(LDS_TAB + CH_LAST * 16 <= LDS_BYTES, "LDS map");
constexpr int TR_PITCH = 65, TR_WAVE_BYTES = 64 * TR_PITCH * 4;
static_assert(8 * TR_WAVE_BYTES <= LDS_MISC && STAGE_BYTES <= LDS_MISC, "LDS map");

struct Params { const float* in[16]; float* out; unsigned char* ws; int lo, hi; };
enum { IN_X = 0, IN_AWIN, IN_ACONV, IN_AWOUT, IN_KVW, IN_BWQ, IN_BWO, IN_FG, IN_FU, IN_FD, IN_MR, IN_MG, IN_MU, IN_MD, IN_LNG, IN_LNB };

__device__ __forceinline__ void tr_item(const float* src, int ldw, bf16_t* dst, int K, LAS float* scr, int lane) {
    f32x4 v[16];
    const int q = lane >> 4, c4 = (lane & 15) * 4;
#pragma unroll
    for (int i = 0; i < 16; ++i) v[i] = *(const f32x4*)(src + (size_t)(4 * i + q) * ldw + c4);
#pragma unroll
    for (int i = 0; i < 16; ++i) { LAS float* s = scr + (4 * i + q) * TR_PITCH + c4; s[0] = v[i][0]; s[1] = v[i][1]; s[2] = v[i][2]; s[3] = v[i][3]; }
    asm volatile("s_waitcnt lgkmcnt(0)" ::: "memory");
    const int c = lane & 7;
#pragma unroll
    for (int j = 0; j < 8; ++j) { const int n = (lane >> 3) + 8 * j; const LAS float* s = scr + (8 * c) * TR_PITCH + n;
        u32x4 o; o.x = cvt_pk_bf16(s[0 * TR_PITCH], s[1 * TR_PITCH]); o.y = cvt_pk_bf16(s[2 * TR_PITCH], s[3 * TR_PITCH]); o.z = cvt_pk_bf16(s[4 * TR_PITCH], s[5 * TR_PITCH]); o.w = cvt_pk_bf16(s[6 * TR_PITCH], s[7 * TR_PITCH]);
        *(u32x4*)(dst + (size_t)n * K + 8 * c) = o; }
    asm volatile("s_waitcnt lgkmcnt(0)" ::: "memory");
}
__device__ __forceinline__ int tr_plain(int it, int NGW, const float* W, int ldw, int K, int ncols, bf16_t* dst, LAS float* scr, int lane) {
    const int ncb = ncols / 64, nit = (K / 64) * ncb;
    for (; it < nit; it += NGW) { const int kb = it / ncb, nb = it % ncb; tr_item(W + (size_t)(64 * kb) * ldw + 64 * nb, ldw, dst + (size_t)(64 * nb) * K + 64 * kb, K, scr, lane); }
    return it - nit;
}
__device__ __forceinline__ int tr_gu(int it, int NGW, const float* Wg, const float* Wu, int ldw, int K, int F, bf16_t* dst, LAS float* scr, int lane) {
    const int nrb = 2 * F / 64, nit = (K / 64) * nrb;
    for (; it < nit; it += NGW) { const int kb = it / nrb, rb = it % nrb, t = rb >> 2, sub = rb & 3;
        const float* W = (sub < 2 ? Wg : Wu) + 128 * t + 64 * (sub & 1);
        tr_item(W + (size_t)(64 * kb) * ldw, ldw, dst + (size_t)(64 * rb) * K + 64 * kb, K, scr, lane); }
    return it - nit;
}
__device__ __forceinline__ int tr_moe(int it, int NGW, const float* mg, const float* mu, const float* md, unsigned char* ws, LAS float* scr, int lane) {
    bf16_t* wgu = (bf16_t*)(ws + WS_WM); bf16_t* wdn = (bf16_t*)(ws + WS_WM + SZ_WMGU);
    for (int e = 0; e < NE; ++e) {
        it = tr_gu(it, NGW, mg + (size_t)e * D * DEX, mu + (size_t)e * D * DEX, DEX, D, DEX, wgu + (size_t)e * 2 * DEX * D, scr, lane);
        it = tr_plain(it, NGW, md + (size_t)e * DEX * D, D, DEX, D, wdn + (size_t)e * D * DEX, scr, lane);
    }
    return it;
}
__device__ __forceinline__ void p0_phase(const Params& p, LAS unsigned char* lds, int G, int bx) {
    const int tid = opaque_tid(), lane = tid & 63, wave = __builtin_amdgcn_readfirstlane(tid >> 6);
    LAS float* scr = (LAS float*)(lds + wave * TR_WAVE_BYTES);
    const int NGW = G * 8; int it = bx * 8 + wave;
    unsigned char* ws = p.ws;
    for (int l = 0; l < 2; ++l) {
        const float* win = p.in[IN_AWIN] + (size_t)l * D * 3 * D; bf16_t* d = (bf16_t*)(ws + WS_WIN + l * SZ_WIN);
        it = tr_gu(it, NGW, win + D, win + 2 * D, 3 * D, D, D, d, scr, lane);
        it = tr_plain(it, NGW, win, 3 * D, D, D, d + (size_t)2 * D * D, scr, lane);
        it = tr_plain(it, NGW, p.in[IN_AWOUT] + (size_t)l * D * D, D, D, D, (bf16_t*)(ws + WS_WOUT + l * SZ_WOUT), scr, lane);
        it = tr_plain(it, NGW, p.in[IN_BWO] + (size_t)l * ATTW * D, D, ATTW, D, (bf16_t*)(ws + WS_WO + l * SZ_WO), scr, lane);
        it = tr_gu(it, NGW, p.in[IN_FG] + (size_t)l * D * DFF, p.in[IN_FU] + (size_t)l * D * DFF, DFF, D, DFF, (bf16_t*)(ws + WS_WGU + l * SZ_WGU), scr, lane);
        it = tr_plain(it, NGW, p.in[IN_FD] + (size_t)l * DFF * D, D, DFF, D, (bf16_t*)(ws + WS_WDN + l * SZ_WDN), scr, lane);
    }
    it = tr_plain(it, NGW, p.in[IN_BWQ], NQ, D, NQ, (bf16_t*)(ws + WS_WQKV2), scr, lane);
    it = tr_plain(it, NGW, p.in[IN_KVW], NKV, D, NKV, (bf16_t*)(ws + WS_WQKV2) + (size_t)NQ * D, scr, lane);
    it = tr_plain(it, NGW, p.in[IN_BWQ] + (size_t)D * NQ, NQ, D, NQ, (bf16_t*)(ws + WS_WQ3), scr, lane);
    it = tr_moe(it, NGW, p.in[IN_MG], p.in[IN_MU], p.in[IN_MD], ws, scr, lane);
    const f32x4* xs = (const f32x4*)p.in[IN_X]; u32x4* xd = (u32x4*)(ws + WS_XA);
    for (size_t i = (size_t)bx * NTHR + tid; i < (size_t)M * D / 8; i += (size_t)G * NTHR) { const f32x4 a = xs[2 * i], b = xs[2 * i + 1]; xd[i] = pack8(a, b); }
}

__device__ __forceinline__ void conv_phase(const bf16_t* CU, const bf16_t* GB, bf16_t* Gb, const float* cw, int G, int bx) {
    const int tid = opaque_tid(), ch = (tid & 127) * 8, sub = tid >> 7;
    float w0[8], w1[8], w2[8];
#pragma unroll
    for (int j = 0; j < 8; ++j) { w0[j] = cw[ch + j]; w1[j] = cw[D + ch + j]; w2[j] = cw[2 * D + ch + j]; }
    for (int blk = bx; blk < M / 256; blk += G) {
        const int m0 = blk * 256 + sub * 64;
        u32x4 p2 = (u32x4){0u, 0u, 0u, 0u}, p1 = p2;
        if ((m0 & (SEQ - 1)) != 0) { p2 = *(const u32x4*)(CU + (size_t)(m0 - 2) * D + ch); p1 = *(const u32x4*)(CU + (size_t)(m0 - 1) * D + ch); }
#pragma unroll 4
        for (int i = 0; i < 64; ++i) { const size_t off = (size_t)(m0 + i) * D + ch;
            const u32x4 c0 = *(const u32x4*)(CU + off), gv = *(const u32x4*)(GB + off);
            const unsigned a2[4] = {p2.x, p2.y, p2.z, p2.w}, a1[4] = {p1.x, p1.y, p1.z, p1.w}, a0[4] = {c0.x, c0.y, c0.z, c0.w}, gg[4] = {gv.x, gv.y, gv.z, gv.w};
            unsigned o[4];
#pragma unroll
            for (int j = 0; j < 4; ++j) {
                const float lo = bf_lo(gg[j]) * (w0[2 * j] * bf_lo(a2[j]) + w1[2 * j] * bf_lo(a1[j]) + w2[2 * j] * bf_lo(a0[j]));
                const float hi = bf_hi(gg[j]) * (w0[2 * j + 1] * bf_hi(a2[j]) + w1[2 * j + 1] * bf_hi(a1[j]) + w2[2 * j + 1] * bf_hi(a0[j]));
                o[j] = cvt_pk_bf16(lo, hi); }
            *(u32x4*)(Gb + off) = (u32x4){o[0], o[1], o[2], o[3]};
            p2 = p1; p1 = c0; }
    }
}

template <int MODE>
__device__ __forceinline__ void ln_phase(const Params& p, LAS unsigned char* lds, const bf16_t* Y, const float* gam, const float* bet, const float* wrt, int G, int bx) {
    const int tid = opaque_tid(), lane = tid & 63, wave = __builtin_amdgcn_readfirstlane(tid >> 6);
    unsigned char* ws = p.ws;
    bf16_t* xa = (bf16_t*)(ws + WS_XA);
    const bf16_t* y2 = (const bf16_t*)(ws + WS_BIG + BG_Y2);
    f32x4 gv[4], bv[4];
#pragma unroll
    for (int jj = 0; jj < 4; ++jj) { gv[jj] = *(const f32x4*)(gam + 4 * lane + 256 * jj); bv[jj] = *(const f32x4*)(bet + 4 * lane + 256 * jj); }
    float wr8[MODE == 1 ? 16 : 1][8];
    if (MODE == 1) {
#pragma unroll
        for (int jj = 0; jj < 4; ++jj)
#pragma unroll
            for (int ii = 0; ii < 4; ++ii) { const f32x4 a = *(const f32x4*)(wrt + (size_t)(4 * lane + 256 * jj + ii) * NE), b = *(const f32x4*)(wrt + (size_t)(4 * lane + 256 * jj + ii) * NE + 4);
                wr8[MODE == 1 ? jj * 4 + ii : 0][0] = a[0]; wr8[MODE == 1 ? jj * 4 + ii : 0][1] = a[1]; wr8[MODE == 1 ? jj * 4 + ii : 0][2] = a[2]; wr8[MODE == 1 ? jj * 4 + ii : 0][3] = a[3];
                wr8[MODE == 1 ? jj * 4 + ii : 0][4] = b[0]; wr8[MODE == 1 ? jj * 4 + ii : 0][5] = b[1]; wr8[MODE == 1 ? jj * 4 + ii : 0][6] = b[2]; wr8[MODE == 1 ? jj * 4 + ii : 0][7] = b[3]; }
    }
    LAS int* tabE = (LAS int*)lds;
    LAS float* tabG = (LAS float*)(lds + 2048);
    LAS int* wcnt = (LAS int*)(lds + 4096);
    for (int blk = bx; blk < M / 256; blk += G) {
        u32x2 pa[4], pb[4], pc[4];
#define LN_LOAD(rw) do { const size_t o_ = (size_t)(rw) * D + 4 * lane; _Pragma("unroll") for (int jj = 0; jj < 4; ++jj) { \
            if (MODE <= 1) pa[jj] = *(const u32x2*)(Y + o_ + 256 * jj); \
            else { pa[jj] = *(const u32x2*)(xa + o_ + 256 * jj); pb[jj] = *(const u32x2*)(y2 + o_ + 256 * jj); pc[jj] = *(const u32x2*)(y2 + (size_t)M * D + o_ + 256 * jj); } } } while (0)
        LN_LOAD((size_t)blk * 256 + wave * 32);
        for (int i = 0; i < 32; ++i) {
            const int rl = wave * 32 + i; const size_t row = (size_t)blk * 256 + rl;
            f32x4 v[4];
#pragma unroll
            for (int jj = 0; jj < 4; ++jj) {
                if (MODE <= 1) { v[jj][0] = bf_lo(pa[jj].x); v[jj][1] = bf_hi(pa[jj].x); v[jj][2] = bf_lo(pa[jj].y); v[jj][3] = bf_hi(pa[jj].y); }
                else { v[jj][0] = ALPHA * bf_lo(pa[jj].x) + (bf_lo(pb[jj].x) + bf_lo(pc[jj].x)); v[jj][1] = ALPHA * bf_hi(pa[jj].x) + (bf_hi(pb[jj].x) + bf_hi(pc[jj].x));
                       v[jj][2] = ALPHA * bf_lo(pa[jj].y) + (bf_lo(pb[jj].y) + bf_lo(pc[jj].y)); v[jj][3] = ALPHA * bf_hi(pa[jj].y) + (bf_hi(pb[jj].y) + bf_hi(pc[jj].y)); } }
            if (i + 1 < 32) LN_LOAD(row + 1);
            float s = 0.f;
#pragma unroll
            for (int jj = 0; jj < 4; ++jj) s += (v[jj][0] + v[jj][1]) + (v[jj][2] + v[jj][3]);
            const float mean = wave_sum(s) * (1.0f / D); float s2 = 0.f;
#pragma unroll
            for (int jj = 0; jj < 4; ++jj) { v[jj] = v[jj] - mean; s2 += (v[jj][0] * v[jj][0] + v[jj][1] * v[jj][1]) + (v[jj][2] * v[jj][2] + v[jj][3] * v[jj][3]); }
            const float rstd = 1.0f / sqrtf(wave_sum(s2) * (1.0f / D) + LN_EPS);
#pragma unroll
            for (int jj = 0; jj < 4; ++jj) v[jj] = v[jj] * rstd * gv[jj] + bv[jj];
            if (MODE == 3) {
#pragma unroll
                for (int jj = 0; jj < 4; ++jj) *(f32x4*)(p.out + row * D + 4 * lane + 256 * jj) = v[jj];
            } else {
#pragma unroll
                for (int jj = 0; jj < 4; ++jj) { u32x2 o; o.x = cvt_pk_bf16(v[jj][0], v[jj][1]); o.y = cvt_pk_bf16(v[jj][2], v[jj][3]); *(u32x2*)(xa + row * D + 4 * lane + 256 * jj) = o; }
            }
            if (MODE == 1) {
                float lg[8];
#pragma unroll
                for (int e = 0; e < 8; ++e) { float a = 0.f;
#pragma unroll
                    for (int jj = 0; jj < 4; ++jj)
#pragma unroll
                        for (int ii = 0; ii < 4; ++ii) a += v[jj][ii] * wr8[MODE == 1 ? jj * 4 + ii : 0][e];
                    lg[e] = wave_sum(a); }
                int b1 = 0; float v1 = lg[0];
#pragma unroll
                for (int e = 1; e < 8; ++e) if (lg[e] > v1) { v1 = lg[e]; b1 = e; }
                int b2 = -1; float v2 = 0.f;
#pragma unroll
                for (int e = 0; e < 8; ++e) if (e != b1 && (b2 < 0 || lg[e] > v2)) { v2 = lg[e]; b2 = e; }
                const float ex = __expf(v2 - v1), g1 = 1.0f / (1.0f + ex), g2 = ex * g1;
                if (lane == 0) { tabE[rl * 2] = b1; tabE[rl * 2 + 1] = b2; tabG[rl * 2] = g1; tabG[rl * 2 + 1] = g2; }
            }
        }
        if (MODE == 1) {
            __syncthreads();
            const int e = tabE[tid]; int rank = 0;
#pragma unroll
            for (int x = 0; x < 8; ++x) { const unsigned long long mk = __ballot(e == x); if (e == x) rank = __popcll(mk & ((1ull << lane) - 1ull)); if (lane == 0) wcnt[wave * 8 + x] = __popcll(mk); }
            __syncthreads();
            for (int j = 0; j < wave; ++j) rank += wcnt[j * 8 + e];
            const int ent = blk * 512 + tid;
            ((int*)(ws + WS_ROUTE + RT_TOKE))[ent] = e; ((float*)(ws + WS_ROUTE + RT_TOKG))[ent] = tabG[tid]; ((int*)(ws + WS_ROUTE + RT_TOKR))[ent] = rank;
            if (tid < 8) { int c = 0; for (int j = 0; j < 8; ++j) c += wcnt[j * 8 + tid]; ((int*)(ws + CTL_CNT))[blk * 8 + tid] = c; }
            __syncthreads();
        }
    }
}

#undef LN_LOAD
__device__ __forceinline__ void scatter_phase(const Params& p, LAS unsigned char* lds, int G, int bx) {
    unsigned char* ws = p.ws; const int tid = opaque_tid(), lane = tid & 63, wave = __builtin_amdgcn_readfirstlane(tid >> 6);
    LAS int* cnt = (LAS int*)lds;
    LAS int* seg = (LAS int*)(lds + 8192);
    LAS int* base = (LAS int*)(lds + 8192 + 64);
    LAS int* eslot = (LAS int*)(lds + 8192 + 128);
    const int* gcnt = (const int*)(ws + CTL_CNT);
    const bf16_t* xa = (const bf16_t*)(ws + WS_XA); bf16_t* xg = (bf16_t*)p.out;
    int* slot_tok = (int*)(ws + WS_ROUTE + RT_SLOTT); float* slot_gate = (float*)(ws + WS_ROUTE + RT_SLOTG); int* tok_slot = (int*)(ws + WS_ROUTE + RT_TOKS);
    for (int i = tid; i < 2048; i += NTHR) cnt[i] = ld_agent(gcnt + i);
    __syncthreads();
    if (tid < 8) { int tot = 0; for (int w = 0; w < 256; ++w) tot += cnt[w * 8 + tid]; seg[8 + tid] = tot; }
    __syncthreads();
    if (tid == 0) { int s = 0; for (int e = 0; e < 8; ++e) { seg[e] = s; s += seg[8 + e]; } }
    __syncthreads();
    if (bx == 0) {
        int* tab = (int*)(ws + CTL_TAB);
        for (int t = tid; t < TILE_CAP; t += NTHR) { int e = 0, cb = 0, s0 = 0, n = 0, run = 0, segs = 0;
#pragma unroll
            for (int k = 0; k < 8; ++k) { const int nk = seg[8 + k], tk = (nk + 255) >> 8; if (t >= run && t < run + tk) { e = k; cb = run; s0 = segs; n = nk; } run += tk; segs += nk; }
            int v0 = 0, v1 = 0, v2 = 0, v3 = 0;
            if (t < run) { const int st = s0 + 256 * (t - cb), row0 = st < NSLOT - 256 ? st : NSLOT - 256, en = (st + 256 < s0 + n) ? st + 256 : s0 + n; v0 = e; v1 = row0; v2 = st - row0; v3 = en - row0; }
            tab[4 * t] = v0; tab[4 * t + 1] = v1; tab[4 * t + 2] = v2; tab[4 * t + 3] = v3;
            if (t == 0) ((int*)(ws + CTL_META))[0] = run; }
    }
    for (int blk = bx; blk < M / 256; blk += G) {
        if (tid < 8) { int b = seg[tid]; for (int w = 0; w < blk; ++w) b += cnt[w * 8 + tid]; base[tid] = b; }
        __syncthreads();
        { const int ent = blk * 512 + tid; const int e = ((const int*)(ws + WS_ROUTE + RT_TOKE))[ent], rk = ((const int*)(ws + WS_ROUTE + RT_TOKR))[ent];
          const float gt = ((const float*)(ws + WS_ROUTE + RT_TOKG))[ent]; const int slot = base[e] + rk;
          slot_tok[slot] = ent; slot_gate[slot] = gt; tok_slot[ent] = slot; eslot[tid] = slot; }
        __syncthreads();
        for (int i = 0; i < 64; i += 4) {
            u32x4 v[4][2]; int sl[4];
#pragma unroll
            for (int k = 0; k < 4; ++k) { const int en = wave * 64 + i + k; sl[k] = eslot[en]; const u32x4* s = (const u32x4*)(xa + (size_t)(blk * 256 + (en >> 1)) * D); v[k][0] = s[lane]; v[k][1] = s[64 + lane]; }
#pragma unroll
            for (int k = 0; k < 4; ++k) { u32x4* d = (u32x4*)(xg + (size_t)sl[k] * D); d[lane] = v[k][0]; d[64 + lane] = v[k][1]; }
        }
        __syncthreads();
    }
}

constexpr int AT_P = 72;
constexpr int AT_BLK = 128 * AT_P;
__device__ __forceinline__ void attn_phase(LAS unsigned char* lds, const bf16_t* Qt, const bf16_t* Kt, const bf16_t* Vt, bf16_t* OG, float* LSE, int G, int bx) {
    const int tid = opaque_tid(), lane = tid & 63, wave = __builtin_amdgcn_readfirstlane(tid >> 6);
    LAS bf16_t* Kr = (LAS bf16_t*)lds; LAS bf16_t* Vr = Kr + 3 * AT_BLK;
    const int c = lane & 15, gq = lane >> 4, q4 = c >> 2, p4 = c & 3;
    const int q0 = 16 * wave;
    const float SC = 0.125f * 1.4426950408889634f;
    for (int i = tid; i < 2 * 3 * AT_BLK * 2 / 16; i += NTHR) ((LAS u32x4*)lds)[i] = (u32x4){0u, 0u, 0u, 0u};
    __syncthreads();
#define AT_DECODE(e, g, r, n) int g, r, n; if ((e) <= 16) { g = 0; r = 0; n = (e) == 0 ? 15 : 16 * half + (e) - 1; } else if ((e) <= 32) { g = 1; r = 2 * half + (((e) - 17) >> 3); n = ((e) - 17) & 7; } else { g = 2; r = half + 2 * (((e) - 33) >> 1); n = ((e) - 33) & 1; }
    for (int su = bx; su < 256; su += G) {
        const int b = su >> 4, h = (su >> 1) & 7, half = su & 1;
        const int e0 = half ? 0 : 1;
        u32x4 rk[2], rv[2], rq[2], rqn[2];
        rq[0] = rq[1] = (u32x4){0u, 0u, 0u, 0u};
#define AT_LOAD(e, RQ) do { AT_DECODE(e, g_, r_, n_); const int L_ = 4096 >> (2 * g_); const size_t seg_ = ((size_t)((b * 3 + g_) * 8 + h) * 4096 + (size_t)r_ * L_ + (size_t)n_ * 128) * 64; \
        _Pragma("unroll") for (int i_ = 0; i_ < 2; ++i_) { rk[i_] = *(const u32x4*)(Kt + seg_ + (size_t)(tid + 512 * i_) * 8); rv[i_] = *(const u32x4*)(Vt + seg_ + (size_t)(tid + 512 * i_) * 8); } \
        _Pragma("unroll") for (int ks_ = 0; ks_ < 2; ++ks_) RQ[ks_] = *(const u32x4*)(Qt + seg_ + (size_t)(q0 + c) * 64 + 32 * ks_ + 8 * gq); } while (0)
#define AT_WRITE(slot) do { _Pragma("unroll") for (int i_ = 0; i_ < 2; ++i_) { const int id_ = tid + 512 * i_; \
        *(LAS u32x4*)(Kr + (slot) * AT_BLK + (id_ >> 3) * AT_P + (id_ & 7) * 8) = rk[i_]; *(LAS u32x4*)(Vr + (slot) * AT_BLK + (id_ >> 3) * AT_P + (id_ & 7) * 8) = rv[i_]; } } while (0)
        AT_LOAD(e0, rq);
        __syncthreads();
        AT_WRITE(e0 % 3);
        asm volatile("" : "+v"(rq[0]), "+v"(rq[1]));
        __syncthreads();
        for (int e = e0; e < 49; ++e) {
            if (e + 1 < 49) AT_LOAD(e + 1, rqn);
            if (e > 0) {
                AT_DECODE(e, g, r, n);
                const int cur = e % 3, prv = (e + 2) % 3;
                const int tskip = (n == 0) ? 8 - wave : 0;
                bf16x8 qf[2]; __builtin_memcpy(&qf[0], &rq[0], 16); __builtin_memcpy(&qf[1], &rq[1], 16);
                f32x4 s[9];
#pragma unroll
                for (int t = 0; t < 9; ++t) { s[t] = (f32x4){0.f, 0.f, 0.f, 0.f};
                    if (t >= tskip) { const int kb = q0 + 16 * t; const LAS bf16_t* kp = Kr + ((kb >> 7) ? cur : prv) * AT_BLK + ((kb & 127) + c) * AT_P + 8 * gq;
#pragma unroll
                        for (int ks = 0; ks < 2; ++ks) { const bf16x8 kf = *(const LAS bf16x8*)(kp + 32 * ks); s[t] = __builtin_amdgcn_mfma_f32_16x16x32_bf16(kf, qf[ks], s[t], 0, 0, 0); } } }
#pragma unroll
                for (int jx = 0; jx < 4; ++jx) { if (4 * gq + jx < c) s[0][jx] = -INFINITY; if (4 * gq + jx > c) s[8][jx] = -INFINITY; }
                float mx = -INFINITY;
#pragma unroll
                for (int t = 0; t < 9; ++t) { if (t < tskip) s[t] = (f32x4){-INFINITY, -INFINITY, -INFINITY, -INFINITY};
#pragma unroll
                    for (int jx = 0; jx < 4; ++jx) mx = fmaxf(mx, s[t][jx]); }
                mx = fmaxf(mx, shx(mx, 16, lane)); mx = fmaxf(mx, shx(mx, 32, lane));
                const float mxs = mx * SC; float ls = 0.f;
#pragma unroll
                for (int t = 0; t < 9; ++t)
#pragma unroll
                    for (int jx = 0; jx < 4; ++jx) { const float pv = __builtin_amdgcn_exp2f(s[t][jx] * SC - mxs); s[t][jx] = pv; ls += pv; }
                ls += shx(ls, 16, lane); ls += shx(ls, 32, lane);
                f32x4 o[4];
#pragma unroll
                for (int dt = 0; dt < 4; ++dt) o[dt] = (f32x4){0.f, 0.f, 0.f, 0.f};
#pragma unroll
                for (int s5 = 0; s5 < 4; ++s5) {
                    if (2 * s5 + 1 >= tskip) {
                        const u32x4 pw = pack8(s[2 * s5], s[2 * s5 + 1]); bf16x8 pf; __builtin_memcpy(&pf, &pw, 16);
                        const int kb0 = q0 + 32 * s5, kb1 = kb0 + 16;
                        const LAS bf16_t* vp0 = Vr + ((kb0 >> 7) ? cur : prv) * AT_BLK + ((kb0 & 127) + 4 * gq + q4) * AT_P + 4 * p4;
                        const LAS bf16_t* vp1 = Vr + ((kb1 >> 7) ? cur : prv) * AT_BLK + ((kb1 & 127) + 4 * gq + q4) * AT_P + 4 * p4;
#pragma unroll
                        for (int dt = 0; dt < 4; ++dt) {
                            const bf16x4 v0 = __builtin_amdgcn_ds_read_tr16_b64_v4i16((LAS bf16x4*)(vp0 + 16 * dt));
                            const bf16x4 v1 = __builtin_amdgcn_ds_read_tr16_b64_v4i16((LAS bf16x4*)(vp1 + 16 * dt));
                            const bf16x8 vf = (bf16x8){v0[0], v0[1], v0[2], v0[3], v1[0], v1[1], v1[2], v1[3]};
                            o[dt] = __builtin_amdgcn_mfma_f32_16x16x32_bf16(vf, pf, o[dt], 0, 0, 0); } } }
                {
                    u32x2 pw; pw.x = cvt_pk_bf16(s[8][0], s[8][1]); pw.y = cvt_pk_bf16(s[8][2], s[8][3]); bf16x4 pf4; __builtin_memcpy(&pf4, &pw, 8);
                    const LAS bf16_t* vp = Vr + cur * AT_BLK + (q0 + 4 * gq + q4) * AT_P + 4 * p4;
#pragma unroll
                    for (int dt = 0; dt < 4; ++dt) { const bf16x4 v0 = __builtin_amdgcn_ds_read_tr16_b64_v4i16((LAS bf16x4*)(vp + 16 * dt)); o[dt] = __builtin_amdgcn_mfma_f32_16x16x16bf16_1k(v0, pf4, o[dt], 0, 0, 0); } }
                const float inv = 1.0f / ls;
                const int token = b * 4096 + (((n * 128 + q0 + c) << (2 * g)) + r);
                bf16_t* od = OG + ((size_t)token * 3 + g) * ATTW + h * 64 + 4 * gq;
#pragma unroll
                for (int dt = 0; dt < 4; ++dt) { u32x2 w; w.x = cvt_pk_bf16(o[dt][0] * inv, o[dt][1] * inv); w.y = cvt_pk_bf16(o[dt][2] * inv, o[dt][3] * inv); *(u32x2*)(od + 16 * dt) = w; }
                if (gq == 0) LSE[((size_t)token * 3 + g) * 8 + h] = (mxs + __builtin_amdgcn_logf(ls)) * 0.6931471805599453f;
            }
            if (e + 1 < 49) AT_WRITE((e + 1) % 3);
            __syncthreads();
            rq[0] = rqn[0]; rq[1] = rqn[1];
        }
#undef AT_LOAD
#undef AT_WRITE
    }
#undef AT_DECODE
}
__device__ __forceinline__ void combine_phase(const bf16_t* OG, const float* LSE, bf16_t* O, int G, int bx) {
    const int tid = opaque_tid();
    for (size_t it = (size_t)bx * NTHR + tid; it < (size_t)M * 64; it += (size_t)G * NTHR) {
        const size_t token = it >> 6; const int h = (int)(it >> 3) & 7, ch = (int)it & 7;
        const float l0 = LSE[(token * 3 + 0) * 8 + h], l1 = LSE[(token * 3 + 1) * 8 + h], l2 = LSE[(token * 3 + 2) * 8 + h];
        const float mx = fmaxf(l0, fmaxf(l1, l2)); float w0 = __expf(l0 - mx), w1 = __expf(l1 - mx), w2 = __expf(l2 - mx); const float inv = 1.0f / (w0 + w1 + w2); w0 *= inv; w1 *= inv; w2 *= inv;
        const u32x4 a = *(const u32x4*)(OG + (token * 3 + 0) * ATTW + h * 64 + ch * 8), b = *(const u32x4*)(OG + (token * 3 + 1) * ATTW + h * 64 + ch * 8), c = *(const u32x4*)(OG + (token * 3 + 2) * ATTW + h * 64 + ch * 8);
        const unsigned aa[4] = {a.x, a.y, a.z, a.w}, bb[4] = {b.x, b.y, b.z, b.w}, cc[4] = {c.x, c.y, c.z, c.w}; unsigned o[4];
#pragma unroll
        for (int j = 0; j < 4; ++j) o[j] = cvt_pk_bf16(w0 * bf_lo(aa[j]) + w1 * bf_lo(bb[j]) + w2 * bf_lo(cc[j]), w0 * bf_hi(aa[j]) + w1 * bf_hi(bb[j]) + w2 * bf_hi(cc[j]));
        *(u32x4*)(O + token * ATTW + h * 64 + ch * 8) = (u32x4){o[0], o[1], o[2], o[3]};
    }
}

__global__ void __launch_bounds__(NTHR, 2) mk_fwd(Params p) {
    extern __shared__ __attribute__((aligned(16))) unsigned char lds_raw[];
    LAS unsigned char* lds = (LAS unsigned char*)lds_raw;
    constexpr int G = NWG; const int bx = blockIdx.x;
    unsigned char* ws = p.ws;
    volatile LAS unsigned* MISC = (volatile LAS unsigned*)(lds + LDS_MISC);
    if (threadIdx.x < 4) MISC[threadIdx.x] = 0u;
    __syncthreads();
    XcdBarrier bar = xcd_barrier_post((unsigned*)(ws + WS_CTL) + CW_BAR, MISC);
    int pc = 0;
#define PH_IF if (pc >= p.lo && pc < p.hi)
#define PH_END do { if (pc >= p.lo && pc + 1 < p.hi) xcd_barrier(bar); ++pc; } while (0)
    bf16_t* xa = (bf16_t*)(ws + WS_XA);
    unsigned char* big = ws + WS_BIG;
    const float* ln_g = p.in[IN_LNG]; const float* ln_b = p.in[IN_LNB];

    PH_IF { p0_phase(p, lds, G, opq_i(bx)); } PH_END;

    for (int pr = 0; pr < 2; ++pr) {
        for (int q = 0; q < 2; ++q) {
            const int l = 2 * pr + q;
            bf16_t* ysrc;
            if (pr == 0) {
                PH_IF { Gemm g{xa, (const bf16_t*)(ws + WS_WIN + l * SZ_WIN), D}; DenseOrder S; S.init(M, 3 * D, G, opq_i(bx), 0);
                        EpiCU E{(bf16_t*)(big + BG_CU), (bf16_t*)(big + BG_GB)}; gemm_phase(lds, g, S, E); } PH_END;
                PH_IF { conv_phase((const bf16_t*)(big + BG_CU), (const bf16_t*)(big + BG_GB), (bf16_t*)(big + BG_G), p.in[IN_ACONV] + (size_t)l * 3 * D, G, opq_i(bx)); } PH_END;
                ysrc = (bf16_t*)p.out;
            } else {
                PH_IF { Gemm g{xa, (const bf16_t*)(ws + (q == 0 ? WS_WQKV2 : WS_WQ3)), D}; DenseOrder S; S.init(M, q == 0 ? NQ + NKV : NQ, G, opq_i(bx), 0);
                        EpiQKV E{(bf16_t*)((unsigned char*)p.out + DO_Q), (bf16_t*)(big + BG_K)}; gemm_phase(lds, g, S, E); } PH_END;
                PH_IF { attn_phase(lds, (const bf16_t*)((unsigned char*)p.out + DO_Q), (const bf16_t*)(big + BG_K), (const bf16_t*)(big + BG_V), (bf16_t*)(big + BG_OG), (float*)(big + BG_LSE), G, opq_i(bx)); } PH_END;
                PH_IF { combine_phase((const bf16_t*)(big + BG_OG), (const float*)(big + BG_LSE), (bf16_t*)((unsigned char*)p.out + DO_O), G, opq_i(bx)); } PH_END;
                ysrc = (bf16_t*)(big + BG_YATT);
            }
            PH_IF { Gemm g; if (pr == 0) g = Gemm{(const bf16_t*)(big + BG_G), (const bf16_t*)(ws + WS_WOUT + l * SZ_WOUT), D}; else g = Gemm{(const bf16_t*)((unsigned char*)p.out + DO_O), (const bf16_t*)(ws + WS_WO + q * SZ_WO), ATTW};
                    DenseOrder S; S.init(M, D, G, opq_i(bx), 0); EpiResid E{ysrc, xa}; gemm_phase(lds, g, S, E); } PH_END;
            if (q == 0) { PH_IF { ln_phase<0>(p, lds, ysrc, ln_g + (size_t)(l * 2) * D, ln_b + (size_t)(l * 2) * D, nullptr, G, opq_i(bx)); } PH_END; }
            else        { PH_IF { ln_phase<1>(p, lds, ysrc, ln_g + (size_t)(l * 2) * D, ln_b + (size_t)(l * 2) * D, p.in[IN_MR] + (size_t)pr * D * NE, G, opq_i(bx)); } PH_END; }
            if (q == 0) {
                for (int hf = 0; hf < 2; ++hf) {
                    PH_IF { Gemm g{xa + (size_t)hf * (M / 2) * D, (const bf16_t*)(ws + WS_WGU + pr * SZ_WGU), D}; DenseOrder S; S.init(M / 2, 2 * DFF, G, opq_i(bx), 0);
                            EpiSwiGLU E{(bf16_t*)(big + BG_HH), DFF}; gemm_phase(lds, g, S, E); } PH_END;
                    PH_IF { Gemm g{(const bf16_t*)(big + BG_HH), (const bf16_t*)(ws + WS_WDN + pr * SZ_WDN), DFF}; DenseOrder S; S.init(M / 2, D, G, opq_i(bx), hf * (M / 2));
                            EpiResid E{(bf16_t*)p.out, xa}; gemm_phase(lds, g, S, E); } PH_END;
                }
                PH_IF { ln_phase<0>(p, lds, (const bf16_t*)p.out, ln_g + (size_t)(l * 2 + 1) * D, ln_b + (size_t)(l * 2 + 1) * D, nullptr, G, opq_i(bx)); } PH_END;
            } else {
                PH_IF { scatter_phase(p, lds, G, opq_i(bx)); } PH_END;
                for (int cch = 0; cch < NCHUNK; ++cch) {
                    PH_IF { const int T = __builtin_amdgcn_readfirstlane(ld_agent((const int*)(ws + CTL_META))); const int t0 = cch * CH_TILES; int nt = T - t0; const int cap = (cch == NCHUNK - 1) ? CH_LAST : CH_TILES; nt = nt < 0 ? 0 : (nt > cap ? cap : nt);
                            const int row0c = moe_tab_to_lds((const int*)(ws + CTL_TAB), t0, nt, (LAS int*)(lds + LDS_TAB));
                            Gemm g{(const bf16_t*)p.out, (const bf16_t*)(ws + WS_WM), D}; MoeOrder S{(const LAS int*)(lds + LDS_TAB), nt, 2 * DEX / BM, G, opq_i(bx), row0c, 2 * DEX, 0};
                            EpiSwiGLU E{(bf16_t*)(big + BG_HC), DEX}; gemm_phase(lds, g, S, E); } PH_END;
                    PH_IF { const int T = __builtin_amdgcn_readfirstlane(ld_agent((const int*)(ws + CTL_META))); const int t0 = cch * CH_TILES; int nt = T - t0; const int cap = (cch == NCHUNK - 1) ? CH_LAST : CH_TILES; nt = nt < 0 ? 0 : (nt > cap ? cap : nt);
                            const int row0c = moe_tab_to_lds((const int*)(ws + CTL_TAB), t0, nt, (LAS int*)(lds + LDS_TAB));
                            Gemm g{(const bf16_t*)(big + BG_HC), (const bf16_t*)(ws + WS_WM + SZ_WMGU), DEX}; MoeOrder S{(const LAS int*)(lds + LDS_TAB), nt, D / BM, G, opq_i(bx), row0c, D, 1};
                            EpiMoeDown E{(bf16_t*)(big + BG_Y2), (const int*)(ws + WS_ROUTE + RT_SLOTT), (const float*)(ws + WS_ROUTE + RT_SLOTG)}; gemm_phase(lds, g, S, E); } PH_END;
                }
                if (l == 1) { PH_IF { ln_phase<2>(p, lds, nullptr, ln_g + (size_t)(l * 2 + 1) * D, ln_b + (size_t)(l * 2 + 1) * D, nullptr, G, opq_i(bx));
                                      __syncthreads();
                                      const int t2 = opaque_tid(), wave2 = __builtin_amdgcn_readfirstlane(t2 >> 6); LAS float* scr = (LAS float*)(lds + wave2 * TR_WAVE_BYTES);
                                      tr_moe(opq_i(bx) * 8 + wave2, G * 8, p.in[IN_MG] + (size_t)NE * D * DEX, p.in[IN_MU] + (size_t)NE * D * DEX, p.in[IN_MD] + (size_t)NE * DEX * D, ws, scr, t2 & 63); } PH_END; }
                else        { PH_IF { ln_phase<3>(p, lds, nullptr, ln_g + (size_t)(l * 2 + 1) * D, ln_b + (size_t)(l * 2 + 1) * D, nullptr, G, opq_i(bx)); } PH_END; }
            }
        }
    }
#undef PH_IF
#undef PH_END
}
constexpr int NPHASE = 49;

#if MK_DEBUG
enum { K_P0 = 0, K_GIN, K_CONV, K_RESA, K_LN0, K_LN1, K_GU, K_DN, K_LNF, K_SCAT, K_MGU, K_MDN, K_LNM, K_QKV, K_ATT, K_COMB, K_RESB };
__device__ __forceinline__ float bf2f(bf16_t v) { return __uint_as_float((unsigned)v << 16); }
__device__ float dot_a(const bf16_t* a, const float* W, int ldw, int K, float& nrm) { float s = 0.f, q = 0.f; for (int k = 0; k < K; ++k) { const float t = bf2f(a[k]) * W[(size_t)k * ldw]; s += t; q += t * t; } nrm = sqrtf(q); return s; }
__device__ bool closef(float got, float ref, float nrm) { return fabsf(got - ref) <= 0.02f * fabsf(ref) + 0.02f * nrm + 2e-3f && got == got; }
__device__ unsigned hsh(unsigned x) { x ^= x >> 16; x *= 0x7feb352du; x ^= x >> 15; x *= 0x846ca68bu; x ^= x >> 16; return x; }
__device__ int pick_row(unsigned sid, int nrows) { switch (sid) { case 0: return 0; case 1: return 1; case 2: return 255; case 3: return 256; case 4: return 257; case 5: return nrows - 1; case 6: return nrows - 256; case 7: return nrows / 2 + 127; default: break; } return (int)(hsh(sid * 2u + 1u) % (unsigned)nrows); }
__global__ void mk_check(Params p, int kind, int l, int a0, int pc) {
    const unsigned sid = blockIdx.x * blockDim.x + threadIdx.x; unsigned char* ws = p.ws; unsigned char* big = ws + WS_BIG;
    unsigned* dbg = (unsigned*)(ws + WS_CTL) + CW_DBG; const bf16_t* xa = (const bf16_t*)(ws + WS_XA);
    bool ok = true; float n1, n2;
    if (kind == K_GIN) { const int m = pick_row(sid, M), c = hsh(sid) % D; const float* W = p.in[IN_AWIN] + (size_t)l * D * 3 * D;
        const float rb = dot_a(xa + (size_t)m * D, W + c, 3 * D, D, n1); ok = closef(bf2f(((const bf16_t*)(big + BG_GB))[(size_t)m * D + c]), rb, n1);
        const float rc = dot_a(xa + (size_t)m * D, W + D + c, 3 * D, D, n1), ru = dot_a(xa + (size_t)m * D, W + 2 * D + c, 3 * D, D, n2);
        ok = ok && closef(bf2f(((const bf16_t*)(big + BG_CU))[(size_t)m * D + c]), rc * ru, fabsf(rc) * n2 + fabsf(ru) * n1);
    } else if (kind == K_CONV) { const int m = pick_row(sid, M), c = hsh(sid) % D, s = m & (SEQ - 1); const bf16_t* CU = (const bf16_t*)(big + BG_CU); const float* cw = p.in[IN_ACONV] + (size_t)l * 3 * D;
        float cv = cw[2 * D + c] * bf2f(CU[(size_t)m * D + c]); if (s >= 1) cv += cw[D + c] * bf2f(CU[(size_t)(m - 1) * D + c]); if (s >= 2) cv += cw[c] * bf2f(CU[(size_t)(m - 2) * D + c]);
        const float ref = bf2f(((const bf16_t*)(big + BG_GB))[(size_t)m * D + c]) * cv; ok = closef(bf2f(((const bf16_t*)(big + BG_G))[(size_t)m * D + c]), ref, 0.f);
    } else if (kind == K_RESA) { const int m = pick_row(sid, M), c = hsh(sid) % D; const float ref = ALPHA * bf2f(xa[(size_t)m * D + c]) + dot_a((const bf16_t*)(big + BG_G) + (size_t)m * D, p.in[IN_AWOUT] + (size_t)l * D * D + c, D, D, n1);
        ok = closef(bf2f(((const bf16_t*)p.out)[(size_t)m * D + c]), ref, n1);
    } else if (kind == K_RESB) { const int m = pick_row(sid, M), c = hsh(sid) % D; const float ref = ALPHA * bf2f(xa[(size_t)m * D + c]) + dot_a((const bf16_t*)((unsigned char*)p.out + DO_O) + (size_t)m * ATTW, p.in[IN_BWO] + (size_t)(l - 2) * ATTW * D + c, D, ATTW, n1);
        ok = closef(bf2f(((const bf16_t*)(big + BG_YATT))[(size_t)m * D + c]), ref, n1);
    } else if (kind == K_LN0 || kind == K_LN1 || kind == K_LNF) { const int m = pick_row(sid, M), c = hsh(sid) % D; const bf16_t* Yb = (kind == K_LNF || l < 2) ? (const bf16_t*)p.out : (const bf16_t*)(big + BG_YATT); const int which = (kind == K_LNF) ? 1 : 0;
        const float* gm = p.in[IN_LNG] + (size_t)(l * 2 + which) * D; const float* bt = p.in[IN_LNB] + (size_t)(l * 2 + which) * D;
        float mu = 0.f; for (int k = 0; k < D; ++k) mu += bf2f(Yb[(size_t)m * D + k]); mu /= D; float var = 0.f; for (int k = 0; k < D; ++k) { const float d = bf2f(Yb[(size_t)m * D + k]) - mu; var += d * d; } var /= D; const float rs = 1.0f / sqrtf(var + LN_EPS);
        ok = closef(bf2f(xa[(size_t)m * D + c]), (bf2f(Yb[(size_t)m * D + c]) - mu) * rs * gm[c] + bt[c], 0.f);
        if (kind == K_LN1) { const float* wr = p.in[IN_MR] + (size_t)(l / 2) * D * NE; int b1 = -1, b2 = -1; float v1 = -1e30f, v2 = -1e30f, v3 = -1e30f;
            for (int e = 0; e < 8; ++e) { float a = 0.f; for (int k = 0; k < D; ++k) a += ((bf2f(Yb[(size_t)m * D + k]) - mu) * rs * gm[k] + bt[k]) * wr[k * NE + e];
                if (a > v1) { v3 = v2; v2 = v1; b2 = b1; v1 = a; b1 = e; } else if (a > v2) { v3 = v2; v2 = a; b2 = e; } else if (a > v3) v3 = a; }
            const int e1 = ((const int*)(ws + WS_ROUTE + RT_TOKE))[m * 2], e2 = ((const int*)(ws + WS_ROUTE + RT_TOKE))[m * 2 + 1]; const float g1 = ((const float*)(ws + WS_ROUTE + RT_TOKG))[m * 2], g2 = ((const float*)(ws + WS_ROUTE + RT_TOKG))[m * 2 + 1];
            const bool tie = (v1 - v2 < 1e-3f) || (v2 - v3 < 1e-3f); const float r1 = 1.0f / (1.0f + expf(v2 - v1));
            if (!tie) ok = ok && e1 == b1 && e2 == b2 && fabsf(g1 - r1) < 2e-3f && fabsf(g1 + g2 - 1.0f) < 1e-4f; }
    } else if (kind == K_GU) { const int mr = pick_row(sid, M / 2), f = hsh(sid) % DFF, m = a0 * (M / 2) + mr; const int i = l / 2;
        const float rg = dot_a(xa + (size_t)m * D, p.in[IN_FG] + (size_t)i * D * DFF + f, DFF, D, n1), ru = dot_a(xa + (size_t)m * D, p.in[IN_FU] + (size_t)i * D * DFF + f, DFF, D, n2);
        const float sg = rg / (1.0f + expf(-rg)); ok = closef(bf2f(((const bf16_t*)(big + BG_HH))[(size_t)mr * DFF + f]), sg * ru, fabsf(sg) * n2 + fabsf(ru) * n1);
    } else if (kind == K_DN) { const int mr = pick_row(sid, M / 2), c = hsh(sid) % D, m = a0 * (M / 2) + mr; const int i = l / 2;
        const float ref = ALPHA * bf2f(xa[(size_t)m * D + c]) + dot_a((const bf16_t*)(big + BG_HH) + (size_t)mr * DFF, p.in[IN_FD] + (size_t)i * DFF * D + c, D, DFF, n1); ok = closef(bf2f(((const bf16_t*)p.out)[(size_t)m * D + c]), ref, n1);
    } else if (kind == K_SCAT) { const int* tok_slot = (const int*)(ws + WS_ROUTE + RT_TOKS); const int* slot_tok = (const int*)(ws + WS_ROUTE + RT_SLOTT); const int* tok_e = (const int*)(ws + WS_ROUTE + RT_TOKE); const int* gcnt = (const int*)(ws + CTL_CNT);
        for (int ent = sid; ent < NSLOT; ent += gridDim.x * blockDim.x) { const int slot = tok_slot[ent]; if (slot < 0 || slot >= NSLOT || slot_tok[slot] != ent) ok = false; }
        const int ent = hsh(sid) % NSLOT, slot = tok_slot[ent], e = tok_e[ent]; int s0 = 0, n = 0; for (int x = 0; x < 8; ++x) { int t = 0; for (int w = 0; w < 256; ++w) t += gcnt[w * 8 + x]; if (x < e) s0 += t; if (x == e) n = t; }
        if (slot >= 0 && slot < NSLOT) { if (slot < s0 || slot >= s0 + n) ok = false; const int c = hsh(sid + 77u) % D; if (((const bf16_t*)p.out)[(size_t)slot * D + c] != xa[(size_t)(ent >> 1) * D + c]) ok = false; }
        if (sid == 0) { const int T = ((const int*)(ws + CTL_META))[0]; if (T < 512 || T > 520) ok = false; }
    } else if (kind == K_MGU || kind == K_MDN) { const int* tab = (const int*)(ws + CTL_TAB); const int T = ((const int*)(ws + CTL_META))[0]; const int t0 = a0 * CH_TILES; int nt = T - t0; const int cap = (a0 == NCHUNK - 1) ? CH_LAST : CH_TILES; nt = nt < 0 ? 0 : (nt > cap ? cap : nt);
        if (nt > 0) { const int t = t0 + hsh(sid) % nt, e = tab[4 * t], row0 = tab[4 * t + 1], lo = tab[4 * t + 2], hi = tab[4 * t + 3], row0c = tab[4 * t0 + 1];
            const int r = (sid & 3) == 0 ? lo : ((sid & 3) == 1 ? hi - 1 : lo + hsh(sid + 5u) % (hi - lo)); const int slot = row0 + r; const int i = l / 2;
            const int ent = ((const int*)(ws + WS_ROUTE + RT_SLOTT))[slot]; if (((const int*)(ws + WS_ROUTE + RT_TOKE))[ent] != e) ok = false;
            const bf16_t* hrow = (const bf16_t*)(big + BG_HC) + (size_t)(slot - row0c) * DEX;
            if (kind == K_MGU) { const int f = hsh(sid + 9u) % DEX; const bf16_t* xr = (const bf16_t*)p.out + (size_t)slot * D; const size_t wo = ((size_t)i * NE + e) * D * DEX + f;
                const float rg = dot_a(xr, p.in[IN_MG] + wo, DEX, D, n1), ru = dot_a(xr, p.in[IN_MU] + wo, DEX, D, n2); const float sg = rg / (1.0f + expf(-rg));
                ok = ok && closef(bf2f(hrow[f]), sg * ru, fabsf(sg) * n2 + fabsf(ru) * n1);
            } else { const int c = hsh(sid + 9u) % D; const float gt = ((const float*)(ws + WS_ROUTE + RT_SLOTG))[slot];
                const float ref = gt * dot_a(hrow, p.in[IN_MD] + ((size_t)i * NE + e) * DEX * D + c, D, DEX, n1);
                ok = ok && closef(bf2f(((const bf16_t*)(big + BG_Y2))[((size_t)(ent & 1) * M + (ent >> 1)) * D + c]), ref, gt * n1); } }
    } else if (kind == K_QKV) { const int m = pick_row(sid, M), ncol = (l == 2) ? NQ + NKV : NQ, c = hsh(sid) % ncol; float ref; bf16_t got;
        if (c < NQ) { ref = dot_a(xa + (size_t)m * D, p.in[IN_BWQ] + (size_t)(l - 2) * D * NQ + c, NQ, D, n1); got = ((const bf16_t*)((unsigned char*)p.out + DO_Q))[resid_off(m, c >> 9, (c >> 6) & 7, c & 63)]; }
        else { const int c2 = c - NQ; ref = dot_a(xa + (size_t)m * D, p.in[IN_KVW] + c2, NKV, D, n1); got = ((const bf16_t*)(big + (((c2 >> 9) & 1) ? BG_V : BG_K)))[resid_off(m, c2 >> 10, (c2 >> 6) & 7, c2 & 63)]; }
        ok = closef(bf2f(got), ref, n1);
    } else if (kind == K_ATT) { const int m = pick_row(sid, M), g = hsh(sid) % 3, h = hsh(sid + 3u) % 8, d = 1 << (2 * g), b = m >> 12, s = m & 4095; const bf16_t* Q = (const bf16_t*)((unsigned char*)p.out + DO_Q); const bf16_t* K = (const bf16_t*)(big + BG_K); const bf16_t* V = (const bf16_t*)(big + BG_V);
        float mx = -1e30f; const int ev = hsh(sid + 11u) % 64; float den = 0.f, o = 0.f;
        for (int pass = 0; pass < 2; ++pass) for (int j = 0; j <= 128; ++j) { const int sk = s - j * d; if (sk < 0) break; float a = 0.f; for (int e = 0; e < 64; ++e) a += bf2f(Q[resid_off(m, g, h, e)]) * bf2f(K[resid_off(b * 4096 + sk, g, h, e)]); a *= 0.125f;
            if (pass == 0) mx = fmaxf(mx, a); else { const float pe = expf(a - mx); den += pe; o += pe * bf2f(V[resid_off(b * 4096 + sk, g, h, ev)]); } }
        o /= den; const int e = ev;
        ok = closef(bf2f(((const bf16_t*)(big + BG_OG))[((size_t)m * 3 + g) * ATTW + h * 64 + e]), o, 0.02f) && closef(((const float*)(big + BG_LSE))[((size_t)m * 3 + g) * 8 + h], mx + logf(den), 0.05f);
    } else if (kind == K_COMB) { const int m = pick_row(sid, M), h = hsh(sid) % 8, e = hsh(sid + 3u) % 64; const float* L = (const float*)(big + BG_LSE) + (size_t)m * 24 + h; const float mx = fmaxf(L[0], fmaxf(L[8], L[16]));
        const float w0 = expf(L[0] - mx), w1 = expf(L[8] - mx), w2 = expf(L[16] - mx); const bf16_t* og = (const bf16_t*)(big + BG_OG) + (size_t)m * 3 * ATTW + h * 64 + e;
        ok = closef(bf2f(((const bf16_t*)((unsigned char*)p.out + DO_O))[(size_t)m * ATTW + h * 64 + e]), (w0 * bf2f(og[0]) + w1 * bf2f(og[ATTW]) + w2 * bf2f(og[2 * ATTW])) / (w0 + w1 + w2), 0.02f);
    }
    if (!ok) atomicAdd(&dbg[1 + pc], 1u);
    if (sid == 0 && ((const unsigned*)(ws + WS_CTL))[CW_BAR + XB_TMO] != 0u) atomicAdd(&dbg[1 + 98], 1u);
}
__global__ void mk_report(float* out, const unsigned* dbg) {
    int code = 0; for (int pc = 0; pc < 99 && code == 0; ++pc) if (dbg[1 + pc] > (pc == 98 ? 0u : 12u)) code = pc + 1;
    if (code == 0) return;
    const float V = sqrtf(100.0f * (float)code);
    for (size_t i = (size_t)blockIdx.x * blockDim.x + threadIdx.x; i < (size_t)M * D; i += (size_t)gridDim.x * blockDim.x) out[i] = V;
}
#endif
}

extern "C" void kernel_launch(void* const* d_in, const int* in_sizes, int n_in, void* d_out, int out_size, void* d_ws, size_t ws_size, hipStream_t stream) {
    using namespace mk;
    static int grid = 0;
    if (grid == 0) {
        if (n_in != 16 || in_sizes[0] != M * D || out_size != M * D || ws_size < WS_NEED) { fprintf(stderr, "kernel_launch: unexpected shapes (n_in %d, in0 %d, out %d, ws %zu, need %zu)\n", n_in, n_in > 0 ? in_sizes[0] : -1, out_size, ws_size, (size_t)WS_NEED); grid = -1; return; }
        int dev = 0, cus = 0, per_cu = 0;
        if (hipGetDevice(&dev) != hipSuccess || hipDeviceGetAttribute(&cus, hipDeviceAttributeMultiprocessorCount, dev) != hipSuccess) { grid = -1; return; }
        if (hipFuncSetAttribute((const void*)mk_fwd, hipFuncAttributeMaxDynamicSharedMemorySize, LDS_BYTES) != hipSuccess) { fprintf(stderr, "kernel_launch: hipFuncSetAttribute failed\n"); grid = -1; return; }
        if (hipOccupancyMaxActiveBlocksPerMultiprocessor(&per_cu, (const void*)mk_fwd, NTHR, LDS_BYTES) != hipSuccess || per_cu < 1) fprintf(stderr, "kernel_launch: occupancy query reports %d\n", per_cu);
        (void)hipGetLastError();
        if (cus != NWG) { fprintf(stderr, "kernel_launch: built for %d CUs, device has %d\n", NWG, cus); grid = -1; return; }
        grid = NWG;
    }
    if (grid < 0) return;
    (void)hipMemsetAsync((char*)d_ws + WS_CTL, 0, CTL_ZERO_BYTES, stream);
    Params p{};
    for (int i = 0; i < 16; ++i) p.in[i] = (const float*)d_in[i];
    p.out = (float*)d_out; p.ws = (unsigned char*)d_ws; p.lo = 0; p.hi = NPHASE;
#if !MK_DEBUG
    hipLaunchKernelGGL(mk_fwd, dim3(grid), dim3(NTHR), LDS_BYTES, stream, p);
#else
    int pc = 0;
    auto run = [&](int kind, int l, int a0) { p.lo = pc; p.hi = pc + 1; hipLaunchKernelGGL(mk_fwd, dim3(grid), dim3(NTHR), LDS_BYTES, stream, p);
        if (kind != K_P0 && kind != K_LNM) hipLaunchKernelGGL(mk_check, dim3(4), dim3(256), 0, stream, p, kind, l, a0, pc); ++pc; };
    run(K_P0, 0, 0);
    for (int pr = 0; pr < 2; ++pr) for (int q = 0; q < 2; ++q) { const int l = 2 * pr + q;
        if (pr == 0) { run(K_GIN, l, 0); run(K_CONV, l, 0); run(K_RESA, l, 0); } else { run(K_QKV, l, 0); run(K_ATT, l, 0); run(K_COMB, l, 0); run(K_RESB, l, 0); }
        run(q == 0 ? K_LN0 : K_LN1, l, 0);
        if (q == 0) { for (int hf = 0; hf < 2; ++hf) { run(K_GU, l, hf); run(K_DN, l, hf); } run(K_LNF, l, 0); }
        else { run(K_SCAT, l, 0); for (int c = 0; c < NCHUNK; ++c) { run(K_MGU, l, c); run(K_MDN, l, c); } run(K_LNM, l, 0); } }
    if (pc != NPHASE) fprintf(stderr, "kernel_launch: debug phase enumeration mismatch %d\n", pc);
    hipLaunchKernelGGL(mk_report, dim3(1024), dim3(256), 0, stream, (float*)d_out, (const unsigned*)((char*)d_ws + WS_CTL) + CW_DBG);
#endif
}
```

```cpp
#include <hip/hip_runtime.h>
#include <cstdio>
#include <cstdint>

#ifndef MK_DEBUG
#define MK_DEBUG 0
#endif

namespace mk {
#define LAS __attribute__((address_space(3)))
typedef unsigned short bf16_t;
typedef short bf16x8 __attribute__((ext_vector_type(8)));
typedef short bf16x4 __attribute__((ext_vector_type(4)));
typedef float f32x4 __attribute__((ext_vector_type(4)));
typedef unsigned u32x4 __attribute__((ext_vector_type(4)));
typedef unsigned u32x2 __attribute__((ext_vector_type(2)));

constexpr int NB = 16, SEQ = 4096, D = 1024, M = NB * SEQ;
constexpr int DFF = 2816, NE = 8, DEX = 3584, ATTW = 512, NQ = 3 * ATTW, NKV = 6 * ATTW;
constexpr float ALPHA = 1.6817928305074292f;
constexpr float LN_EPS = 1e-5f;
constexpr int NWG = 256, NTHR = 512;
constexpr int NSLOT = 2 * M;
constexpr int CH_TILES = 128, NCHUNK = 4, CH_LAST = 136, TILE_CAP = 640;

constexpr size_t MiB = (size_t)1 << 20;
constexpr size_t WS_CTL = 0;
constexpr size_t CTL_ZERO_BYTES = 64 * 1024;
constexpr int CW_BAR = 1024;
constexpr int CW_DBG = 8192;
constexpr size_t CTL_CNT = 64 * 1024;
constexpr size_t CTL_TAB = 80 * 1024;
constexpr size_t CTL_META = 96 * 1024;
constexpr size_t WS_SMALL = 1 * MiB;
constexpr size_t WS_WIN = WS_SMALL, WS_WOUT = WS_SMALL + 12 * MiB, WS_WQKV2 = WS_SMALL + 16 * MiB, WS_WQ3 = WS_SMALL + 25 * MiB, WS_WO = WS_SMALL + 28 * MiB,
                 WS_WGU = WS_SMALL + 30 * MiB, WS_WDN = WS_SMALL + 52 * MiB;
constexpr size_t SZ_WIN = (size_t)3 * D * D * 2, SZ_WOUT = (size_t)D * D * 2, SZ_WO = (size_t)D * ATTW * 2, SZ_WGU = (size_t)2 * DFF * D * 2, SZ_WDN = (size_t)D * DFF * 2;
constexpr size_t WS_WM = 65 * MiB;
constexpr size_t SZ_WMGU = (size_t)NE * 2 * DEX * D * 2;
constexpr size_t WS_XA = 233 * MiB;
constexpr size_t WS_ROUTE = 361 * MiB;
constexpr size_t RT_TOKE = 0, RT_TOKG = 512 * 1024, RT_TOKR = 1024 * 1024, RT_SLOTT = 1536 * 1024, RT_SLOTG = 2048 * 1024 + 4096, RT_TOKS = 2560 * 1024 + 8192;
constexpr size_t WS_BIG = 365 * MiB;
constexpr size_t BG_CU = 0, BG_GB = 128 * MiB, BG_G = 256 * MiB;
constexpr size_t BG_K = 0, BG_V = 192 * MiB  , BG_OG = 384 * MiB, BG_LSE = 576 * MiB, BG_YATT = 384 * MiB;
constexpr size_t BG_HH = 384 * MiB;
constexpr size_t BG_HC = 0, BG_Y2 = 238 * MiB;
constexpr size_t WS_NEED = WS_BIG + 640 * MiB;
constexpr size_t DO_Q = 0, DO_O = 192 * MiB;

typedef float f32x2c __attribute__((ext_vector_type(2)));
typedef __bf16 bf16x2c __attribute__((ext_vector_type(2)));
__device__ __forceinline__ unsigned cvt_pk_bf16(float lo, float hi) { const f32x2c v = {lo, hi}; return __builtin_bit_cast(unsigned, __builtin_convertvector(v, bf16x2c)); }
__device__ __forceinline__ float bf_lo(unsigned w) { return __uint_as_float(w << 16); }
__device__ __forceinline__ float bf_hi(unsigned w) { return __uint_as_float(w & 0xffff0000u); }
__device__ __forceinline__ int ld_agent(const int* p) { return __hip_atomic_load(p, __ATOMIC_RELAXED, __HIP_MEMORY_SCOPE_AGENT); }
__device__ __forceinline__ int opaque_tid() { int t = threadIdx.x; asm volatile("" : "+v"(t)); return t; }
__device__ __forceinline__ int opq_i(int v) { asm volatile("" : "+s"(v)); return v; }
template <class T> __device__ __forceinline__ T* opq(T* p) { asm volatile("" : "+s"(p)); return p; }
__device__ __forceinline__ float wave_sum(float v) {
    v += __builtin_bit_cast(float, __builtin_amdgcn_update_dpp(0, __builtin_bit_cast(int, v), 0xB1, 0xf, 0xf, true));
    v += __builtin_bit_cast(float, __builtin_amdgcn_update_dpp(0, __builtin_bit_cast(int, v), 0x4E, 0xf, 0xf, true));
    v += __builtin_bit_cast(float, __builtin_amdgcn_update_dpp(0, __builtin_bit_cast(int, v), 0x141, 0xf, 0xf, true));
    v += __builtin_bit_cast(float, __builtin_amdgcn_update_dpp(0, __builtin_bit_cast(int, v), 0x140, 0xf, 0xf, true));
    v += __builtin_bit_cast(float, __builtin_amdgcn_update_dpp(0, __builtin_bit_cast(int, v), 0x142, 0xa, 0xf, false));
    v += __builtin_bit_cast(float, __builtin_amdgcn_update_dpp(0, __builtin_bit_cast(int, v), 0x143, 0xc, 0xf, false));
    return __builtin_bit_cast(float, __builtin_amdgcn_readlane(__builtin_bit_cast(int, v), 63));
}
__device__ __forceinline__ float shx(float v, int o, int lane) { return __builtin_bit_cast(float, __builtin_amdgcn_ds_bpermute((lane ^ o) << 2, __builtin_bit_cast(int, v))); }

#define XB_TMO      128
#define XB_XCNT(j)  (256  + 64 * (j))
#define XB_XSUB(j)  (1280 + 64 * (j))
#define XB_XGEN(j)  (2304 + 64 * (j))
#define XB_TOP      3328
#define XB_TOPGEN   3392
#define XCD_BAR_WORDS 3456
#define XB_SPIN_CAP (1u << 18)
__device__ __forceinline__ unsigned xb_ld(unsigned* p)              { return __hip_atomic_load(p, __ATOMIC_RELAXED, __HIP_MEMORY_SCOPE_AGENT); }
__device__ __forceinline__ unsigned xb_add(unsigned* p, unsigned v) { return __hip_atomic_fetch_add(p, v, __ATOMIC_RELAXED, __HIP_MEMORY_SCOPE_AGENT); }
__device__ __forceinline__ unsigned xb_xcc_id() { return (unsigned)__builtin_amdgcn_s_getreg((3 << 11) | 20) & 0xFu; }
#define XB_SPIN(cond, bar) do { unsigned _sp = 0; while (cond) { __builtin_amdgcn_s_sleep(1); \
    if ((++_sp & 255u) == 0u) { if (xb_ld(&(bar)[XB_TMO])) break; if (_sp > XB_SPIN_CAP) { atomicAdd(&(bar)[XB_TMO], 1u); break; } } } } while (0)
struct XcdBarrier { unsigned* bar; unsigned x; volatile LAS unsigned* st; };
__device__ __forceinline__ XcdBarrier xcd_barrier_post(unsigned* bar, volatile LAS unsigned* st) {
    XcdBarrier b; b.bar = bar; b.x = xb_xcc_id(); b.st = st;
    if (threadIdx.x == 0) (void)xb_add(&bar[XB_XCNT(b.x)], 1u);
    return b;
}
__device__ __forceinline__ void xcd_barrier_complete(unsigned* bar, unsigned x, unsigned& nloc, unsigned& nx) {
    const unsigned G = gridDim.x * gridDim.y * gridDim.z;
    unsigned sum, cnt, mine, sp = 0u;
    for (;;) {
        sum = 0u; cnt = 0u; mine = 0u;
#pragma unroll
        for (unsigned j = 0; j < 16; ++j) { const unsigned c = xb_ld(&bar[XB_XCNT(j)]); sum += c; cnt += (c > 0u) ? 1u : 0u; mine = (j == x) ? c : mine; }
        if (sum == G) break;
        __builtin_amdgcn_s_sleep(1);
        if ((++sp & 255u) == 0u) { if (xb_ld(&bar[XB_TMO])) break; if (sp > XB_SPIN_CAP) { atomicAdd(&bar[XB_TMO], 1u); break; } }
    }
    nloc = mine > 0u ? mine : 1u; nx = cnt > 0u ? cnt : 1u;
}
__device__ __forceinline__ void xcd_barrier(const XcdBarrier& b) {
    asm volatile("s_waitcnt vmcnt(0)" ::: "memory");
    __syncthreads();
    if (threadIdx.x == 0) {
        unsigned* bar = b.bar;
        __builtin_amdgcn_s_waitcnt(0);
        unsigned nloc = b.st[0], nx = b.st[1];
        if (nloc == 0u) { xcd_barrier_complete(bar, b.x, nloc, nx); b.st[0] = nloc; b.st[1] = nx; }
        const unsigned old = xb_add(&bar[XB_XSUB(b.x)], 1u);
        const unsigned gen = old / nloc;
        if (old + 1u == (gen + 1u) * nloc) {
            __builtin_amdgcn_fence(__ATOMIC_RELEASE, "agent");
            asm volatile("s_waitcnt vmcnt(0)" ::: "memory");
            const unsigned og = xb_add(&bar[XB_TOP], 1u);
            const unsigned tg = og / nx;
            if (og + 1u == (tg + 1u) * nx) xb_add(&bar[XB_TOPGEN], 1u);
            else XB_SPIN(xb_ld(&bar[XB_TOPGEN]) == tg, bar);
            __builtin_amdgcn_fence(__ATOMIC_ACQUIRE, "agent");
            xb_add(&bar[XB_XGEN(b.x)], 1u);
            asm volatile("s_waitcnt vmcnt(0)" ::: "memory");
        } else {
            XB_SPIN(xb_ld(&bar[XB_XGEN(b.x)]) == gen, bar);
            __builtin_amdgcn_fence(__ATOMIC_ACQUIRE, "agent");
            asm volatile("s_waitcnt vmcnt(0)" ::: "memory");
        }
    }
    __syncthreads();
}

#ifndef MOE_WGM
#define MOE_WGM 8
#endif
constexpr int BM = 256, BK = 64, HALF = 128, HTB = HALF * BK * 2, STAGE_BYTES = 8 * HTB, NXCD = 8, WGM = 4;
__device__ __forceinline__ int lds_byte(int r, int c) { const int st = (r >> 4) * 2 + (c >> 5), rr = r & 15, cc = c & 31, ob = rr * 64 + cc * 2; return st * 1024 + (ob ^ (((ob >> 9) & 1) << 5)); }
__device__ __forceinline__ void stage_rc(int b, int& R, int& C) { const int st = b / 1024, sb = b % 1024, swz = sb ^ (((sb >> 9) & 1) << 5); R = (st >> 1) * 16 + swz / 64; C = (st & 1) * 32 + (swz % 64) / 2; }
__device__ __forceinline__ int perm32(int rho) { const int n = rho >> 4, i = rho & 15; return 8 * (i >> 2) + 4 * n + (i & 3); }

struct Unit { int arow, brow, orow, pn, lo, hi; };
struct Gemm { const bf16_t* A; const bf16_t* Bt; int K; };

struct DenseOrder {
    static constexpr bool GATHER = false; __device__ __forceinline__ const int* gidx() const { return nullptr; }
    int nM, nN, nwg, G, c, row_base;
    __device__ __forceinline__ void init(int Mrows, int N, int G_, int c_, int row_base_) { nM = Mrows / BM; nN = N / BM; nwg = nM * nN; G = G_; c = c_; row_base = row_base_; }
    __device__ __forceinline__ bool next(int i, Unit& u) const {
        const long L = (long)i * G + c; if (L >= nwg) return false;
        int wgid = (int)L; { const int q = nwg / NXCD, r = nwg % NXCD, xcd = wgid % NXCD, off = wgid / NXCD; wgid = (xcd < r ? xcd * (q + 1) : r * (q + 1) + (xcd - r) * q) + off; }
        const int nig = WGM * nN, gid = wgid / nig, fm = gid * WGM, gsz = (nM - fm) < WGM ? (nM - fm) : WGM;
        const int pm = fm + ((wgid % nig) % gsz), pn = (wgid % nig) / gsz;
        u.arow = pm * BM; u.brow = pn * BM; u.orow = row_base + pm * BM; u.pn = pn; u.lo = 0; u.hi = BM; return true;
    }
};
template <bool GA>
struct MoeOrder {
    static constexpr bool GATHER = GA; const int* gix; __device__ __forceinline__ const int* gidx() const { return gix; }
    const LAS int* tab; int nt, nN, G, c, row0c, brows, down;
    __device__ __forceinline__ bool next(int i, Unit& u) const {
        const int L0 = i * G + c, nwg = nt * nN; if (L0 >= nwg) return false;
        int L = L0; { const int q = nwg / NXCD, r = nwg % NXCD, xcd = L % NXCD, off = L / NXCD; L = (xcd < r ? xcd * (q + 1) : r * (q + 1) + (xcd - r) * q) + off; }
        constexpr int MG = MOE_WGM; const int nig = MG * nN, gid = L / nig, fm = gid * MG, gsz = (nt - fm) < MG ? (nt - fm) : MG, w = L % nig;
        const int tl = fm + w % gsz, pn = w / gsz;
        const LAS int* tt = tab + 4 * tl;
        const int e = __builtin_amdgcn_readfirstlane(tt[0]), row0 = __builtin_amdgcn_readfirstlane(tt[1]);
        u.lo = __builtin_amdgcn_readfirstlane(tt[2]); u.hi = __builtin_amdgcn_readfirstlane(tt[3]);
        u.pn = pn; u.brow = e * brows + pn * BM;
        if (!down) { u.arow = row0; u.orow = row0 - row0c; } else { u.arow = row0 - row0c; u.orow = row0; }
        return true;
    }
};

#define EPI_ROWS(ai, m) ((ai) * HALF + wr * 64 + (m) * 16 + fr)
__device__ __forceinline__ u32x4 pack8(const f32x4& a, const f32x4& b) { u32x4 w; w.x = cvt_pk_bf16(a[0], a[1]); w.y = cvt_pk_bf16(a[2], a[3]); w.z = cvt_pk_bf16(b[0], b[1]); w.w = cvt_pk_bf16(b[2], b[3]); return w; }
__device__ __forceinline__ float silu(float x) { return x * __builtin_amdgcn_rcpf(1.0f + __builtin_amdgcn_exp2f(-1.4426950408889634f * x)); }

struct EpiResid {
    bf16_t* Y; const bf16_t* X;
    __device__ __forceinline__ void operator()(const f32x4 (&acc)[2][2][4][2], const Unit& u, int wr, int wc, int fr, int fq) const {
        const int col0 = u.pn * BM + wc * 32 + 8 * fq;
#pragma unroll
        for (int ai = 0; ai < 2; ++ai)
#pragma unroll
            for (int m = 0; m < 4; ++m) { const size_t off = (size_t)(u.orow + EPI_ROWS(ai, m)) * D + col0;
#pragma unroll
                for (int bj = 0; bj < 2; ++bj) { const u32x4 xv = *(const u32x4*)(X + off + bj * HALF); const f32x4 a0 = acc[ai][bj][m][0], a1 = acc[ai][bj][m][1];
                    f32x4 o0, o1; o0[0] = ALPHA * bf_lo(xv.x) + a0[0]; o0[1] = ALPHA * bf_hi(xv.x) + a0[1]; o0[2] = ALPHA * bf_lo(xv.y) + a0[2]; o0[3] = ALPHA * bf_hi(xv.y) + a0[3];
                    o1[0] = ALPHA * bf_lo(xv.z) + a1[0]; o1[1] = ALPHA * bf_hi(xv.z) + a1[1]; o1[2] = ALPHA * bf_lo(xv.w) + a1[2]; o1[3] = ALPHA * bf_hi(xv.w) + a1[3];
                    *(u32x4*)(Y + off + bj * HALF) = pack8(o0, o1); }
                asm volatile("" ::: "memory"); }
    }
};
struct EpiSwiGLU {
    bf16_t* H; int ldh;
    __device__ __forceinline__ void operator()(const f32x4 (&acc)[2][2][4][2], const Unit& u, int wr, int wc, int fr, int fq) const {
        const int col0 = u.pn * HALF + wc * 32 + 8 * fq;
#pragma unroll
        for (int ai = 0; ai < 2; ++ai)
#pragma unroll
            for (int m = 0; m < 4; ++m) { const int r = EPI_ROWS(ai, m);
                if (r >= u.lo && r < u.hi) { f32x4 h0, h1;
#pragma unroll
                    for (int j = 0; j < 4; ++j) { h0[j] = silu(acc[ai][0][m][0][j]) * acc[ai][1][m][0][j]; h1[j] = silu(acc[ai][0][m][1][j]) * acc[ai][1][m][1][j]; }
                    *(u32x4*)(H + (size_t)(u.orow + r) * ldh + col0) = pack8(h0, h1); } }
    }
};
struct EpiCU {
    bf16_t* CU; bf16_t* GB;
    __device__ __forceinline__ void operator()(const f32x4 (&acc)[2][2][4][2], const Unit& u, int wr, int wc, int fr, int fq) const {
        if (u.pn < 8) { const int col0 = u.pn * HALF + wc * 32 + 8 * fq;
#pragma unroll
            for (int ai = 0; ai < 2; ++ai)
#pragma unroll
                for (int m = 0; m < 4; ++m) { const f32x4 c0 = acc[ai][0][m][0] * acc[ai][1][m][0], c1 = acc[ai][0][m][1] * acc[ai][1][m][1];
                    *(u32x4*)(CU + (size_t)(u.orow + EPI_ROWS(ai, m)) * D + col0) = pack8(c0, c1); }
        } else { const int col0 = (u.pn - 8) * BM + wc * 32 + 8 * fq;
#pragma unroll
            for (int ai = 0; ai < 2; ++ai)
#pragma unroll
                for (int m = 0; m < 4; ++m)
#pragma unroll
                    for (int bj = 0; bj < 2; ++bj) *(u32x4*)(GB + (size_t)(u.orow + EPI_ROWS(ai, m)) * D + col0 + bj * HALF) = pack8(acc[ai][bj][m][0], acc[ai][bj][m][1]);
        }
    }
};
__device__ __forceinline__ size_t resid_off(int token, int g, int h, int e) {
    const int b = token >> 12, s = token & 4095, sh = 2 * g, rr = s & ((1 << sh) - 1), i = s >> sh, L = 4096 >> sh;
    return ((size_t)((b * 3 + g) * 8 + h) * 4096 + (size_t)rr * L + i) * 64 + e;
}
struct EpiQKV {
    bf16_t *Q, *KV;
    __device__ __forceinline__ void operator()(const f32x4 (&acc)[2][2][4][2], const Unit& u, int wr, int wc, int fr, int fq) const {
#pragma unroll
        for (int bj = 0; bj < 2; ++bj) { const int cw = u.pn * BM + bj * HALF + wc * 32;
            const bool isq = cw < NQ; const int c2 = cw - NQ;
            const int g = isq ? (cw >> 9) : (c2 >> 10), h = isq ? ((cw >> 6) & 7) : ((c2 >> 6) & 7);
            bf16_t* dst = KV + (size_t)((c2 >> 9) & 1) * ((size_t)M * 1536); if (isq) dst = Q;
            const int e0 = (cw & 63) + 8 * fq, sh = 2 * g, L = 4096 >> sh;
#pragma unroll
            for (int ai = 0; ai < 2; ++ai)
#pragma unroll
                for (int m = 0; m < 4; ++m) { const int token = u.orow + EPI_ROWS(ai, m), b = token >> 12, s = token & 4095, rr = s & ((1 << sh) - 1), i = s >> sh;
                    *(u32x4*)(dst + ((size_t)((b * 3 + g) * 8 + h) * 4096 + (size_t)(rr * L + i)) * 64 + e0) = pack8(acc[ai][bj][m][0], acc[ai][bj][m][1]);
                    asm volatile("" ::: "memory"); }
        }
    }
};
struct EpiMoeDown {
    bf16_t* Y2; const int* slot_tok; const float* slot_gate;
    __device__ __forceinline__ void operator()(const f32x4 (&acc)[2][2][4][2], const Unit& u, int wr, int wc, int fr, int fq) const {
        const int col0 = u.pn * BM + wc * 32 + 8 * fq;
#pragma unroll
        for (int ai = 0; ai < 2; ++ai)
#pragma unroll
            for (int m = 0; m < 4; ++m) { const int r = EPI_ROWS(ai, m);
                if (r >= u.lo && r < u.hi) { const int ent = slot_tok[u.orow + r]; const float gt = slot_gate[u.orow + r];
                    bf16_t* rowp = Y2 + ((size_t)(ent & 1) * M + (ent >> 1)) * D + col0;
#pragma unroll
                    for (int bj = 0; bj < 2; ++bj) *(u32x4*)(rowp + bj * HALF) = pack8(acc[ai][bj][m][0] * gt, acc[ai][bj][m][1] * gt); } }
    }
};

__device__ __forceinline__ int moe_tab_to_lds(const int* gtab, int t0, int nt, LAS int* ltab) {
    const int tid = opaque_tid();
    for (int i = tid; i < 4 * nt; i += NTHR) ltab[i] = ld_agent(gtab + 4 * t0 + i);
    const int row0c = __builtin_amdgcn_readfirstlane(ld_agent(gtab + 4 * t0 + 1));
    __syncthreads();
    return row0c;
}
template <class Epi, class Sched>
__device__ __forceinline__ void gemm_phase(LAS unsigned char* lds, const Gemm g, const Sched& S, const Epi& E) {
    const int tid = opaque_tid(), wid = __builtin_amdgcn_readfirstlane(tid >> 6), lane = tid & 63, wr = wid >> 2, wc = wid & 3, fr = lane & 15, fq = lane >> 4;
    const int K = g.K, nt = K / BK;
    unsigned voffA[2], voffB[2];
#pragma unroll
    for (int i = 0; i < 2; ++i) { int R, C; stage_rc(tid * 16 + i * 8192, R, C); const int Rb = (R & ~31) + perm32(R & 31);
        voffA[i] = (unsigned)(R * K + C) * 2u; voffB[i] = (unsigned)(Rb * K + C) * 2u; }
    const size_t kstep = (size_t)(BK * 2);
    const size_t hstep = (size_t)HALF * K * 2;
    const size_t rstep = (size_t)K * 2;
    const unsigned ldsw = (unsigned)wid * 1024u;
    const int aoff = lds_byte(wr * 64 + fr, fq * 8), boff = lds_byte(wc * 32 + fr, fq * 8);
#define PG8_SA(b, h) (((b) * 2 + (h)) * HTB)
#define PG8_SB(b, h) ((4 + (b) * 2 + (h)) * HTB)
#define PG8_STAGE(bufoff, gbase, voff) do { _Pragma("unroll") for (int _i = 0; _i < 2; ++_i) \
        __builtin_amdgcn_global_load_lds((const unsigned*)((const char*)(gbase) + (voff)[_i]), (LAS unsigned*)(lds + (bufoff) + ldsw + _i * 8192), 16, 0, 0); } while (0)
#define PG8_LDA(dst, b, h) do { _Pragma("unroll") for (int m = 0; m < 4; ++m) _Pragma("unroll") for (int k = 0; k < 2; ++k) dst[m][k] = *(const LAS bf16x8*)(lds + PG8_SA(b, h) + aoff + m * 2048 + k * 1024); } while (0)
#define PG8_LDB(dst, b, h) do { _Pragma("unroll") for (int n = 0; n < 2; ++n) _Pragma("unroll") for (int k = 0; k < 2; ++k) dst[n][k] = *(const LAS bf16x8*)(lds + PG8_SB(b, h) + boff + n * 2048 + k * 1024); } while (0)
#define PG8_MMA(ai, bj, At, Bt) do { __builtin_amdgcn_s_setprio(1); _Pragma("unroll") for (int m = 0; m < 4; ++m) _Pragma("unroll") for (int n = 0; n < 2; ++n) _Pragma("unroll") for (int k = 0; k < 2; ++k) \
        acc[ai][bj][m][n] = __builtin_amdgcn_mfma_f32_16x16x32_bf16(Bt[n][k], At[m][k], acc[ai][bj][m][n], 0, 0, 0); __builtin_amdgcn_s_setprio(0); } while (0)
#define PG8_WAIT_V(n) asm volatile("s_waitcnt vmcnt(" #n ")" ::: "memory")
#define PG8_WAIT_L(n) asm volatile("s_waitcnt lgkmcnt(" #n ")" ::: "memory")
#define PG8_BAR __builtin_amdgcn_s_barrier()
#define PG8_SCHED __builtin_amdgcn_sched_barrier(0)
    constexpr bool GA = Sched::GATHER;
    unsigned vA[2][2];
#define PG8_GSLOT(h, i) (lds + STAGE_BYTES + ((h) * 2 + (i)) * 2048 + wid * 256)
#define PG8_GDMA(u_) do { _Pragma("unroll") for (int _i = 0; _i < 2; ++_i) { int R_, C_; stage_rc(tid * 16 + _i * 8192, R_, C_); _Pragma("unroll") for (int _h = 0; _h < 2; ++_h) \
        __builtin_amdgcn_global_load_lds((const unsigned*)(S.gidx() + ((u_).arow + _h * HALF + R_)), (LAS unsigned*)PG8_GSLOT(_h, _i), 4, 0, 0); } } while (0)
#define PG8_GOFF_G(u_) do { _Pragma("unroll") for (int _i = 0; _i < 2; ++_i) { int R_, C_; stage_rc(tid * 16 + _i * 8192, R_, C_); _Pragma("unroll") for (int _h = 0; _h < 2; ++_h) \
        vA[_h][_i] = ((unsigned)(S.gidx()[(u_).arow + _h * HALF + R_] >> 1) * (unsigned)K + (unsigned)C_) * 2u; } } while (0)
#define PG8_GOFF_L() do { _Pragma("unroll") for (int _i = 0; _i < 2; ++_i) { int R_, C_; stage_rc(tid * 16 + _i * 8192, R_, C_); _Pragma("unroll") for (int _h = 0; _h < 2; ++_h) \
        vA[_h][_i] = ((unsigned)(*(const LAS int*)(PG8_GSLOT(_h, _i) + lane * 4) >> 1) * (unsigned)K + (unsigned)C_) * 2u; } } while (0)
#define PG8_STAGE_A(bufoff, gbase, h) do { if (GA) PG8_STAGE(bufoff, gbase, vA[h]); else PG8_STAGE(bufoff, (gbase) + (h) * hstep, voffA); } while (0)
    Unit cur, nxt, nn; int ui = 0;
    if (!S.next(0, cur)) return;
    bool has_next = S.next(1, nxt);
    if (GA) { PG8_GOFF_G(cur); if (has_next) PG8_GDMA(nxt); else PG8_GDMA(cur); }
    f32x4 acc[2][2][4][2];
#pragma unroll
    for (int a = 0; a < 2; ++a)
#pragma unroll
        for (int b = 0; b < 2; ++b)
#pragma unroll
            for (int m = 0; m < 4; ++m)
#pragma unroll
                for (int n = 0; n < 2; ++n) acc[a][b][m][n] = (f32x4){0.f, 0.f, 0.f, 0.f};
    bf16x8 At[4][2], B0[2][2], B1[2][2];
    const char* cA = (const char*)g.A + (GA ? (size_t)0 : (size_t)cur.arow * rstep); const char* cB = (const char*)g.Bt + (size_t)cur.brow * rstep;
    PG8_STAGE(PG8_SB(0, 0), cB, voffB); PG8_STAGE(PG8_SB(0, 1), cB + hstep, voffB); PG8_STAGE_A(PG8_SA(0, 0), cA, 0); PG8_STAGE_A(PG8_SA(0, 1), cA, 1);
    if (wr == 1) PG8_BAR;
    PG8_WAIT_V(2); PG8_BAR;
    PG8_STAGE(PG8_SB(1, 0), cB + kstep, voffB); PG8_STAGE_A(PG8_SA(1, 0), cA + kstep, 0); PG8_STAGE(PG8_SB(1, 1), cB + hstep + kstep, voffB);
    PG8_WAIT_V(6); PG8_BAR;
    for (;;) {
        const char* nA = (has_next && !GA) ? (const char*)g.A + (size_t)nxt.arow * rstep : cA; const char* nB = has_next ? (const char*)g.Bt + (size_t)nxt.brow * rstep : cB;
        for (int t = 0; t < nt; t += 2) {
            const bool last = (t == nt - 2);
            const char* a1 = cA + (size_t)(t + 1) * kstep;
            const char* a2 = last ? nA : cA + (size_t)(t + 2) * kstep; const char* b2 = last ? nB : cB + (size_t)(t + 2) * kstep;
            const char* a3 = a2 + kstep; const char* b3 = b2 + kstep;
            PG8_LDB(B0, 0, 0); PG8_LDB(B1, 0, 1); PG8_SCHED; PG8_LDA(At, 0, 0); PG8_STAGE_A(PG8_SA(1, 1), a1, 1);
            PG8_WAIT_V(8); PG8_WAIT_L(0); PG8_BAR; PG8_MMA(0, 0, At, B0); PG8_MMA(0, 1, At, B1); PG8_BAR; PG8_SCHED;
            PG8_LDA(At, 0, 1); PG8_STAGE(PG8_SB(0, 0), b2, voffB); PG8_STAGE(PG8_SB(0, 1), b2 + hstep, voffB);
            if (GA && last) PG8_GOFF_L();
            PG8_STAGE_A(PG8_SA(0, 0), a2, 0);
            PG8_WAIT_V(8); PG8_WAIT_L(0); PG8_BAR; PG8_MMA(1, 0, At, B0); PG8_MMA(1, 1, At, B1); PG8_BAR; PG8_SCHED;
            PG8_LDB(B0, 1, 0); PG8_LDB(B1, 1, 1); PG8_SCHED; PG8_LDA(At, 1, 0); PG8_STAGE_A(PG8_SA(0, 1), a2, 1);
            PG8_WAIT_V(8); PG8_WAIT_L(0); PG8_BAR; PG8_MMA(0, 0, At, B0); PG8_MMA(0, 1, At, B1); PG8_BAR; PG8_SCHED;
            PG8_LDA(At, 1, 1); PG8_STAGE(PG8_SB(1, 0), b3, voffB); PG8_STAGE(PG8_SB(1, 1), b3 + hstep, voffB); PG8_STAGE_A(PG8_SA(1, 0), a3, 0);
            PG8_WAIT_V(8); PG8_WAIT_L(0); PG8_BAR; PG8_MMA(1, 0, At, B0); PG8_MMA(1, 1, At, B1); PG8_BAR; PG8_SCHED;
        }
        const bool has_nn = has_next && S.next(ui + 2, nn);
        if (GA) { if (has_nn) PG8_GDMA(nn); }
        if (wr == 0) PG8_BAR;
        E(acc, cur, wr, wc, fr, fq);
        if (!has_next) break;
#pragma unroll
        for (int a = 0; a < 2; ++a)
#pragma unroll
            for (int b = 0; b < 2; ++b)
#pragma unroll
                for (int m = 0; m < 4; ++m)
#pragma unroll
                    for (int n = 0; n < 2; ++n) acc[a][b][m][n] = (f32x4){0.f, 0.f, 0.f, 0.f};
        cur = nxt; nxt = nn; has_next = has_nn; cA = nA; cB = nB; ++ui;
        if (wr == 1) PG8_BAR;
    }
    PG8_WAIT_V(0);
    PG8_BAR;
#undef PG8_SA
#undef PG8_SB
#undef PG8_STAGE
#undef PG8_STAGE_A
#undef PG8_GSLOT
#undef PG8_GDMA
#undef PG8_GOFF_G
#undef PG8_GOFF_L
#undef PG8_LDA
#undef PG8_LDB
#undef PG8_MMA
#undef PG8_WAIT_V
#undef PG8_WAIT_L
#undef PG8_BAR
#undef PG8_SCHED
}

constexpr int LDS_MISC = 139264;
constexpr int LDS_BYTES = 147456;
constexpr int LDS_TAB = LDS_MISC + 64;
static_assert(LDS_TAB + CH_LAST * 16 <= LDS_BYTES, "LDS map");
constexpr int TR_PITCH = 65, TR_WAVE_BYTES = 64 * TR_PITCH * 4;
static_assert(8 * TR_WAVE_BYTES <= LDS_MISC && STAGE_BYTES <= LDS_MISC, "LDS map");

struct Params { const float* in[16]; float* out; unsigned char* ws; int lo, hi; };
enum { IN_X = 0, IN_AWIN, IN_ACONV, IN_AWOUT, IN_KVW, IN_BWQ, IN_BWO, IN_FG, IN_FU, IN_FD, IN_MR, IN_MG, IN_MU, IN_MD, IN_LNG, IN_LNB };

__device__ __forceinline__ void tr_item(const float* src, int ldw, bf16_t* dst, int K, LAS float* scr, int lane) {
    f32x4 v[16];
    const int q = lane >> 4, c4 = (lane & 15) * 4;
#pragma unroll
    for (int i = 0; i < 16; ++i) v[i] = *(const f32x4*)(src + (size_t)(4 * i + q) * ldw + c4);
#pragma unroll
    for (int i = 0; i < 16; ++i) { LAS float* s = scr + (4 * i + q) * TR_PITCH + c4; s[0] = v[i][0]; s[1] = v[i][1]; s[2] = v[i][2]; s[3] = v[i][3]; }
    asm volatile("s_waitcnt lgkmcnt(0)" ::: "memory");
    const int c = lane & 7;
#pragma unroll
    for (int j = 0; j < 8; ++j) { const int n = (lane >> 3) + 8 * j; const LAS float* s = scr + (8 * c) * TR_PITCH + n;
        u32x4 o; o.x = cvt_pk_bf16(s[0 * TR_PITCH], s[1 * TR_PITCH]); o.y = cvt_pk_bf16(s[2 * TR_PITCH], s[3 * TR_PITCH]); o.z = cvt_pk_bf16(s[4 * TR_PITCH], s[5 * TR_PITCH]); o.w = cvt_pk_bf16(s[6 * TR_PITCH], s[7 * TR_PITCH]);
        *(u32x4*)(dst + (size_t)n * K + 8 * c) = o; }
    asm volatile("s_waitcnt lgkmcnt(0)" ::: "memory");
}
__device__ __forceinline__ int tr_plain(int it, int NGW, const float* W, int ldw, int K, int ncols, bf16_t* dst, LAS float* scr, int lane) {
    const int ncb = ncols / 64, nit = (K / 64) * ncb;
    for (; it < nit; it += NGW) { const int kb = it / ncb, nb = it % ncb; tr_item(W + (size_t)(64 * kb) * ldw + 64 * nb, ldw, dst + (size_t)(64 * nb) * K + 64 * kb, K, scr, lane); }
    return it - nit;
}
__device__ __forceinline__ int tr_gu(int it, int NGW, const float* Wg, const float* Wu, int ldw, int K, int F, bf16_t* dst, LAS float* scr, int lane) {
    const int nrb = 2 * F / 64, nit = (K / 64) * nrb;
    for (; it < nit; it += NGW) { const int kb = it / nrb, rb = it % nrb, t = rb >> 2, sub = rb & 3;
        const float* W = (sub < 2 ? Wg : Wu) + 128 * t + 64 * (sub & 1);
        tr_item(W + (size_t)(64 * kb) * ldw, ldw, dst + (size_t)(64 * rb) * K + 64 * kb, K, scr, lane); }
    return it - nit;
}
__device__ __forceinline__ int tr_moe(int it, int NGW, const float* mg, const float* mu, const float* md, unsigned char* ws, LAS float* scr, int lane) {
    bf16_t* wgu = (bf16_t*)(ws + WS_WM); bf16_t* wdn = (bf16_t*)(ws + WS_WM + SZ_WMGU);
    for (int e = 0; e < NE; ++e) {
        it = tr_gu(it, NGW, mg + (size_t)e * D * DEX, mu + (size_t)e * D * DEX, DEX, D, DEX, wgu + (size_t)e * 2 * DEX * D, scr, lane);
        it = tr_plain(it, NGW, md + (size_t)e * DEX * D, D, DEX, D, wdn + (size_t)e * D * DEX, scr, lane);
    }
    return it;
}
__device__ __forceinline__ void p0_phase(const Params& p, LAS unsigned char* lds, int G, int bx) {
    const int tid = opaque_tid(), lane = tid & 63, wave = __builtin_amdgcn_readfirstlane(tid >> 6);
    LAS float* scr = (LAS float*)(lds + wave * TR_WAVE_BYTES);
    const int NGW = G * 8; int it = bx * 8 + wave;
    unsigned char* ws = p.ws;
    for (int l = 0; l < 2; ++l) {
        const float* win = p.in[IN_AWIN] + (size_t)l * D * 3 * D; bf16_t* d = (bf16_t*)(ws + WS_WIN + l * SZ_WIN);
        it = tr_gu(it, NGW, win + D, win + 2 * D, 3 * D, D, D, d, scr, lane);
        it = tr_plain(it, NGW, win, 3 * D, D, D, d + (size_t)2 * D * D, scr, lane);
        it = tr_plain(it, NGW, p.in[IN_AWOUT] + (size_t)l * D * D, D, D, D, (bf16_t*)(ws + WS_WOUT + l * SZ_WOUT), scr, lane);
        it = tr_plain(it, NGW, p.in[IN_BWO] + (size_t)l * ATTW * D, D, ATTW, D, (bf16_t*)(ws + WS_WO + l * SZ_WO), scr, lane);
        it = tr_gu(it, NGW, p.in[IN_FG] + (size_t)l * D * DFF, p.in[IN_FU] + (size_t)l * D * DFF, DFF, D, DFF, (bf16_t*)(ws + WS_WGU + l * SZ_WGU), scr, lane);
        it = tr_plain(it, NGW, p.in[IN_FD] + (size_t)l * DFF * D, D, DFF, D, (bf16_t*)(ws + WS_WDN + l * SZ_WDN), scr, lane);
    }
    it = tr_plain(it, NGW, p.in[IN_BWQ], NQ, D, NQ, (bf16_t*)(ws + WS_WQKV2), scr, lane);
    it = tr_plain(it, NGW, p.in[IN_KVW], NKV, D, NKV, (bf16_t*)(ws + WS_WQKV2) + (size_t)NQ * D, scr, lane);
    it = tr_plain(it, NGW, p.in[IN_BWQ] + (size_t)D * NQ, NQ, D, NQ, (bf16_t*)(ws + WS_WQ3), scr, lane);
    it = tr_moe(it, NGW, p.in[IN_MG], p.in[IN_MU], p.in[IN_MD], ws, scr, lane);
    const f32x4* xs = (const f32x4*)p.in[IN_X]; u32x4* xd = (u32x4*)(ws + WS_XA);
    for (size_t i = (size_t)bx * NTHR + tid; i < (size_t)M * D / 8; i += (size_t)G * NTHR) { const f32x4 a = xs[2 * i], b = xs[2 * i + 1]; xd[i] = pack8(a, b); }
}

__device__ __forceinline__ void conv_phase(const bf16_t* CU, const bf16_t* GB, bf16_t* Gb, const float* cw, int G, int bx) {
    const int tid = opaque_tid(), ch = (tid & 127) * 8, sub = tid >> 7;
    float w0[8], w1[8], w2[8];
#pragma unroll
    for (int j = 0; j < 8; ++j) { w0[j] = cw[ch + j]; w1[j] = cw[D + ch + j]; w2[j] = cw[2 * D + ch + j]; }
    for (int blk = bx; blk < M / 256; blk += G) {
        const int m0 = blk * 256 + sub * 64;
        u32x4 p2 = (u32x4){0u, 0u, 0u, 0u}, p1 = p2;
        if ((m0 & (SEQ - 1)) != 0) { p2 = *(const u32x4*)(CU + (size_t)(m0 - 2) * D + ch); p1 = *(const u32x4*)(CU + (size_t)(m0 - 1) * D + ch); }
#pragma unroll 4
        for (int i = 0; i < 64; ++i) { const size_t off = (size_t)(m0 + i) * D + ch;
            const u32x4 c0 = *(const u32x4*)(CU + off), gv = *(const u32x4*)(GB + off);
            const unsigned a2[4] = {p2.x, p2.y, p2.z, p2.w}, a1[4] = {p1.x, p1.y, p1.z, p1.w}, a0[4] = {c0.x, c0.y, c0.z, c0.w}, gg[4] = {gv.x, gv.y, gv.z, gv.w};
            unsigned o[4];
#pragma unroll
            for (int j = 0; j < 4; ++j) {
                const float lo = bf_lo(gg[j]) * (w0[2 * j] * bf_lo(a2[j]) + w1[2 * j] * bf_lo(a1[j]) + w2[2 * j] * bf_lo(a0[j]));
                const float hi = bf_hi(gg[j]) * (w0[2 * j + 1] * bf_hi(a2[j]) + w1[2 * j + 1] * bf_hi(a1[j]) + w2[2 * j + 1] * bf_hi(a0[j]));
                o[j] = cvt_pk_bf16(lo, hi); }
            *(u32x4*)(Gb + off) = (u32x4){o[0], o[1], o[2], o[3]};
            p2 = p1; p1 = c0; }
    }
}

template <int MODE>
__device__ __forceinline__ void ln_phase(const Params& p, LAS unsigned char* lds, const bf16_t* Y, const float* gam, const float* bet, const float* wrt, int G, int bx) {
    const int tid = opaque_tid(), lane = tid & 63, wave = __builtin_amdgcn_readfirstlane(tid >> 6);
    unsigned char* ws = p.ws;
    bf16_t* xa = (bf16_t*)(ws + WS_XA);
    const bf16_t* y2 = (const bf16_t*)(ws + WS_BIG + BG_Y2);
    f32x4 gv[4], bv[4];
#pragma unroll
    for (int jj = 0; jj < 4; ++jj) { gv[jj] = *(const f32x4*)(gam + 4 * lane + 256 * jj); bv[jj] = *(const f32x4*)(bet + 4 * lane + 256 * jj); }
    float wr8[MODE == 1 ? 16 : 1][8];
    if (MODE == 1) {
#pragma unroll
        for (int jj = 0; jj < 4; ++jj)
#pragma unroll
            for (int ii = 0; ii < 4; ++ii) { const f32x4 a = *(const f32x4*)(wrt + (size_t)(4 * lane + 256 * jj + ii) * NE), b = *(const f32x4*)(wrt + (size_t)(4 * lane + 256 * jj + ii) * NE + 4);
                wr8[MODE == 1 ? jj * 4 + ii : 0][0] = a[0]; wr8[MODE == 1 ? jj * 4 + ii : 0][1] = a[1]; wr8[MODE == 1 ? jj * 4 + ii : 0][2] = a[2]; wr8[MODE == 1 ? jj * 4 + ii : 0][3] = a[3];
                wr8[MODE == 1 ? jj * 4 + ii : 0][4] = b[0]; wr8[MODE == 1 ? jj * 4 + ii : 0][5] = b[1]; wr8[MODE == 1 ? jj * 4 + ii : 0][6] = b[2]; wr8[MODE == 1 ? jj * 4 + ii : 0][7] = b[3]; }
    }
    LAS int* tabE = (LAS int*)lds;
    LAS float* tabG = (LAS float*)(lds + 2048);
    LAS int* wcnt = (LAS int*)(lds + 4096);
    for (int blk = bx; blk < M / 256; blk += G) {
        u32x2 pa[4], pb[4], pc[4];
#define LN_LOAD(rw) do { const size_t o_ = (size_t)(rw) * D + 4 * lane; _Pragma("unroll") for (int jj = 0; jj < 4; ++jj) { \
            if (MODE <= 1) pa[jj] = *(const u32x2*)(Y + o_ + 256 * jj); \
            else { pa[jj] = *(const u32x2*)(xa + o_ + 256 * jj); pb[jj] = *(const u32x2*)(y2 + o_ + 256 * jj); pc[jj] = *(const u32x2*)(y2 + (size_t)M * D + o_ + 256 * jj); } } } while (0)
        LN_LOAD((size_t)blk * 256 + wave * 32);
        for (int i = 0; i < 32; ++i) {
            const int rl = wave * 32 + i; const size_t row = (size_t)blk * 256 + rl;
            f32x4 v[4];
#pragma unroll
            for (int jj = 0; jj < 4; ++jj) {
                if (MODE <= 1) { v[jj][0] = bf_lo(pa[jj].x); v[jj][1] = bf_hi(pa[jj].x); v[jj][2] = bf_lo(pa[jj].y); v[jj][3] = bf_hi(pa[jj].y); }
                else { v[jj][0] = ALPHA * bf_lo(pa[jj].x) + (bf_lo(pb[jj].x) + bf_lo(pc[jj].x)); v[jj][1] = ALPHA * bf_hi(pa[jj].x) + (bf_hi(pb[jj].x) + bf_hi(pc[jj].x));
                       v[jj][2] = ALPHA * bf_lo(pa[jj].y) + (bf_lo(pb[jj].y) + bf_lo(pc[jj].y)); v[jj][3] = ALPHA * bf_hi(pa[jj].y) + (bf_hi(pb[jj].y) + bf_hi(pc[jj].y)); } }
            if (i + 1 < 32) LN_LOAD(row + 1);
            float s = 0.f;
#pragma unroll
            for (int jj = 0; jj < 4; ++jj) s += (v[jj][0] + v[jj][1]) + (v[jj][2] + v[jj][3]);
            const float mean = wave_sum(s) * (1.0f / D); float s2 = 0.f;
#pragma unroll
            for (int jj = 0; jj < 4; ++jj) { v[jj] = v[jj] - mean; s2 += (v[jj][0] * v[jj][0] + v[jj][1] * v[jj][1]) + (v[jj][2] * v[jj][2] + v[jj][3] * v[jj][3]); }
            const float rstd = 1.0f / sqrtf(wave_sum(s2) * (1.0f / D) + LN_EPS);
#pragma unroll
            for (int jj = 0; jj < 4; ++jj) v[jj] = v[jj] * rstd * gv[jj] + bv[jj];
            if (MODE == 3) {
#pragma unroll
                for (int jj = 0; jj < 4; ++jj) *(f32x4*)(p.out + row * D + 4 * lane + 256 * jj) = v[jj];
            } else {
#pragma unroll
                for (int jj = 0; jj < 4; ++jj) { u32x2 o; o.x = cvt_pk_bf16(v[jj][0], v[jj][1]); o.y = cvt_pk_bf16(v[jj][2], v[jj][3]); *(u32x2*)(xa + row * D + 4 * lane + 256 * jj) = o; }
            }
            if (MODE == 1) {
                float lg[8];
#pragma unroll
                for (int e = 0; e < 8; ++e) { float a = 0.f;
#pragma unroll
                    for (int jj = 0; jj < 4; ++jj)
#pragma unroll
                        for (int ii = 0; ii < 4; ++ii) a += v[jj][ii] * wr8[MODE == 1 ? jj * 4 + ii : 0][e];
                    lg[e] = wave_sum(a); }
                int b1 = 0; float v1 = lg[0];
#pragma unroll
                for (int e = 1; e < 8; ++e) if (lg[e] > v1) { v1 = lg[e]; b1 = e; }
                int b2 = -1; float v2 = 0.f;
#pragma unroll
                for (int e = 0; e < 8; ++e) if (e != b1 && (b2 < 0 || lg[e] > v2)) { v2 = lg[e]; b2 = e; }
                const float ex = __expf(v2 - v1), g1 = 1.0f / (1.0f + ex), g2 = ex * g1;
                if (lane == 0) { tabE[rl * 2] = b1; tabE[rl * 2 + 1] = b2; tabG[rl * 2] = g1; tabG[rl * 2 + 1] = g2; }
            }
        }
        if (MODE == 1) {
            __syncthreads();
            const int e = tabE[tid]; int rank = 0;
#pragma unroll
            for (int x = 0; x < 8; ++x) { const unsigned long long mk = __ballot(e == x); if (e == x) rank = __popcll(mk & ((1ull << lane) - 1ull)); if (lane == 0) wcnt[wave * 8 + x] = __popcll(mk); }
            __syncthreads();
            for (int j = 0; j < wave; ++j) rank += wcnt[j * 8 + e];
            const int ent = blk * 512 + tid;
            ((int*)(ws + WS_ROUTE + RT_TOKE))[ent] = e; ((float*)(ws + WS_ROUTE + RT_TOKG))[ent] = tabG[tid]; ((int*)(ws + WS_ROUTE + RT_TOKR))[ent] = rank;
            if (tid < 8) { int c = 0; for (int j = 0; j < 8; ++j) c += wcnt[j * 8 + tid]; ((int*)(ws + CTL_CNT))[blk * 8 + tid] = c; }
            __syncthreads();
        }
    }
}

#undef LN_LOAD
__device__ __forceinline__ void scatter_phase(const Params& p, LAS unsigned char* lds, int G, int bx) {
    unsigned char* ws = p.ws; const int tid = opaque_tid(), lane = tid & 63, wave = __builtin_amdgcn_readfirstlane(tid >> 6);
    LAS int* cnt = (LAS int*)lds;
    LAS int* seg = (LAS int*)(lds + 8192);
    LAS int* base = (LAS int*)(lds + 8192 + 64);
    LAS int* eslot = (LAS int*)(lds + 8192 + 128);
    const int* gcnt = (const int*)(ws + CTL_CNT);
    const bf16_t* xa = (const bf16_t*)(ws + WS_XA); bf16_t* xg = (bf16_t*)p.out;
    int* slot_tok = (int*)(ws + WS_ROUTE + RT_SLOTT); float* slot_gate = (float*)(ws + WS_ROUTE + RT_SLOTG); int* tok_slot = (int*)(ws + WS_ROUTE + RT_TOKS);
    for (int i = tid; i < 2048; i += NTHR) cnt[i] = ld_agent(gcnt + i);
    __syncthreads();
    if (tid < 8) { int tot = 0; for (int w = 0; w < 256; ++w) tot += cnt[w * 8 + tid]; seg[8 + tid] = tot; }
    __syncthreads();
    if (tid == 0) { int s = 0; for (int e = 0; e < 8; ++e) { seg[e] = s; s += seg[8 + e]; } }
    __syncthreads();
    if (bx == 0) {
        int* tab = (int*)(ws + CTL_TAB);
        for (int t = tid; t < TILE_CAP; t += NTHR) { int e = 0, cb = 0, s0 = 0, n = 0, run = 0, segs = 0;
#pragma unroll
            for (int k = 0; k < 8; ++k) { const int nk = seg[8 + k], tk = (nk + 255) >> 8; if (t >= run && t < run + tk) { e = k; cb = run; s0 = segs; n = nk; } run += tk; segs += nk; }
            int v0 = 0, v1 = 0, v2 = 0, v3 = 0;
            if (t < run) { const int st = s0 + 256 * (t - cb), row0 = st < NSLOT - 256 ? st : NSLOT - 256, en = (st + 256 < s0 + n) ? st + 256 : s0 + n; v0 = e; v1 = row0; v2 = st - row0; v3 = en - row0; }
            tab[4 * t] = v0; tab[4 * t + 1] = v1; tab[4 * t + 2] = v2; tab[4 * t + 3] = v3;
            if (t == 0) ((int*)(ws + CTL_META))[0] = run; }
    }
    for (int blk = bx; blk < M / 256; blk += G) {
        if (tid < 8) { int b = seg[tid]; for (int w = 0; w < blk; ++w) b += cnt[w * 8 + tid]; base[tid] = b; }
        __syncthreads();
        { const int ent = blk * 512 + tid; const int e = ((const int*)(ws + WS_ROUTE + RT_TOKE))[ent], rk = ((const int*)(ws + WS_ROUTE + RT_TOKR))[ent];
          const float gt = ((const float*)(ws + WS_ROUTE + RT_TOKG))[ent]; const int slot = base[e] + rk;
          slot_tok[slot] = ent; slot_gate[slot] = gt; tok_slot[ent] = slot; eslot[tid] = slot; }
        __syncthreads();
        __syncthreads();
    }
}

constexpr int AT_P = 72;
constexpr int AT_BLK = 128 * AT_P;
__device__ __forceinline__ void attn_phase(LAS unsigned char* lds, const bf16_t* Qt, const bf16_t* Kt, const bf16_t* Vt, bf16_t* OG, float* LSE, int G, int bx) {
    const int tid = opaque_tid(), lane = tid & 63, wave = __builtin_amdgcn_readfirstlane(tid >> 6);
    LAS bf16_t* Kr = (LAS bf16_t*)lds; LAS bf16_t* Vr = Kr + 3 * AT_BLK;
    const int c = lane & 15, gq = lane >> 4, q4 = c >> 2, p4 = c & 3;
    const int q0 = 16 * wave;
    const float SC = 0.125f * 1.4426950408889634f;
    for (int i = tid; i < 2 * 3 * AT_BLK * 2 / 16; i += NTHR) ((LAS u32x4*)lds)[i] = (u32x4){0u, 0u, 0u, 0u};
    __syncthreads();
#define AT_DECODE(e, g, r, n) int g, r, n; if ((e) <= 16) { g = 0; r = 0; n = (e) == 0 ? 15 : 16 * half + (e) - 1; } else if ((e) <= 32) { g = 1; r = 2 * half + (((e) - 17) >> 3); n = ((e) - 17) & 7; } else { g = 2; r = half + 2 * (((e) - 33) >> 1); n = ((e) - 33) & 1; }
    for (int su = bx; su < 256; su += G) {
        const int b = su >> 4, h = (su >> 1) & 7, half = su & 1;
        const int e0 = half ? 0 : 1;
        u32x4 rk[2], rv[2], rq[2], rqn[2];
        rq[0] = rq[1] = (u32x4){0u, 0u, 0u, 0u};
#define AT_LOAD(e, RQ) do { AT_DECODE(e, g_, r_, n_); const int L_ = 4096 >> (2 * g_); const size_t seg_ = ((size_t)((b * 3 + g_) * 8 + h) * 4096 + (size_t)r_ * L_ + (size_t)n_ * 128) * 64; \
        _Pragma("unroll") for (int i_ = 0; i_ < 2; ++i_) { rk[i_] = *(const u32x4*)(Kt + seg_ + (size_t)(tid + 512 * i_) * 8); rv[i_] = *(const u32x4*)(Vt + seg_ + (size_t)(tid + 512 * i_) * 8); } \
        _Pragma("unroll") for (int ks_ = 0; ks_ < 2; ++ks_) RQ[ks_] = *(const u32x4*)(Qt + seg_ + (size_t)(q0 + c) * 64 + 32 * ks_ + 8 * gq); } while (0)
#define AT_WRITE(slot) do { _Pragma("unroll") for (int i_ = 0; i_ < 2; ++i_) { const int id_ = tid + 512 * i_; \
        *(LAS u32x4*)(Kr + (slot) * AT_BLK + (id_ >> 3) * AT_P + (id_ & 7) * 8) = rk[i_]; *(LAS u32x4*)(Vr + (slot) * AT_BLK + (id_ >> 3) * AT_P + (id_ & 7) * 8) = rv[i_]; } } while (0)
        AT_LOAD(e0, rq);
        __syncthreads();
        AT_WRITE(e0 % 3);
        asm volatile("" : "+v"(rq[0]), "+v"(rq[1]));
        __syncthreads();
        for (int e = e0; e < 49; ++e) {
            if (e + 1 < 49) AT_LOAD(e + 1, rqn);
            if (e > 0) {
                AT_DECODE(e, g, r, n);
                const int cur = e % 3, prv = (e + 2) % 3;
                const int tskip = (n == 0) ? 8 - wave : 0;
                bf16x8 qf[2]; __builtin_memcpy(&qf[0], &rq[0], 16); __builtin_memcpy(&qf[1], &rq[1], 16);
                f32x4 s[9];
#pragma unroll
                for (int t = 0; t < 9; ++t) { s[t] = (f32x4){0.f, 0.f, 0.f, 0.f};
                    if (t >= tskip) { const int kb = q0 + 16 * t; const LAS bf16_t* kp = Kr + ((kb >> 7) ? cur : prv) * AT_BLK + ((kb & 127) + c) * AT_P + 8 * gq;
#pragma unroll
                        for (int ks = 0; ks < 2; ++ks) { const bf16x8 kf = *(const LAS bf16x8*)(kp + 32 * ks); s[t] = __builtin_amdgcn_mfma_f32_16x16x32_bf16(kf, qf[ks], s[t], 0, 0, 0); } } }
#pragma unroll
                for (int jx = 0; jx < 4; ++jx) { if (4 * gq + jx < c) s[0][jx] = -INFINITY; if (4 * gq + jx > c) s[8][jx] = -INFINITY; }
                float mx = -INFINITY;
#pragma unroll
                for (int t = 0; t < 9; ++t) { if (t < tskip) s[t] = (f32x4){-INFINITY, -INFINITY, -INFINITY, -INFINITY};
#pragma unroll
                    for (int jx = 0; jx < 4; ++jx) mx = fmaxf(mx, s[t][jx]); }
                mx = fmaxf(mx, shx(mx, 16, lane)); mx = fmaxf(mx, shx(mx, 32, lane));
                const float mxs = mx * SC; float ls = 0.f;
#pragma unroll
                for (int t = 0; t < 9; ++t)
#pragma unroll
                    for (int jx = 0; jx < 4; ++jx) { const float pv = __builtin_amdgcn_exp2f(s[t][jx] * SC - mxs); s[t][jx] = pv; ls += pv; }
                ls += shx(ls, 16, lane); ls += shx(ls, 32, lane);
                f32x4 o[4];
#pragma unroll
                for (int dt = 0; dt < 4; ++dt) o[dt] = (f32x4){0.f, 0.f, 0.f, 0.f};
#pragma unroll
                for (int s5 = 0; s5 < 4; ++s5) {
                    if (2 * s5 + 1 >= tskip) {
                        const u32x4 pw = pack8(s[2 * s5], s[2 * s5 + 1]); bf16x8 pf; __builtin_memcpy(&pf, &pw, 16);
                        const int kb0 = q0 + 32 * s5, kb1 = kb0 + 16;
                        const LAS bf16_t* vp0 = Vr + ((kb0 >> 7) ? cur : prv) * AT_BLK + ((kb0 & 127) + 4 * gq + q4) * AT_P + 4 * p4;
                        const LAS bf16_t* vp1 = Vr + ((kb1 >> 7) ? cur : prv) * AT_BLK + ((kb1 & 127) + 4 * gq + q4) * AT_P + 4 * p4;
#pragma unroll
                        for (int dt = 0; dt < 4; ++dt) {
                            const bf16x4 v0 = __builtin_amdgcn_ds_read_tr16_b64_v4i16((LAS bf16x4*)(vp0 + 16 * dt));
                            const bf16x4 v1 = __builtin_amdgcn_ds_read_tr16_b64_v4i16((LAS bf16x4*)(vp1 + 16 * dt));
                            const bf16x8 vf = (bf16x8){v0[0], v0[1], v0[2], v0[3], v1[0], v1[1], v1[2], v1[3]};
                            o[dt] = __builtin_amdgcn_mfma_f32_16x16x32_bf16(vf, pf, o[dt], 0, 0, 0); } } }
                {
                    u32x2 pw; pw.x = cvt_pk_bf16(s[8][0], s[8][1]); pw.y = cvt_pk_bf16(s[8][2], s[8][3]); bf16x4 pf4; __builtin_memcpy(&pf4, &pw, 8);
                    const LAS bf16_t* vp = Vr + cur * AT_BLK + (q0 + 4 * gq + q4) * AT_P + 4 * p4;
#pragma unroll
                    for (int dt = 0; dt < 4; ++dt) { const bf16x4 v0 = __builtin_amdgcn_ds_read_tr16_b64_v4i16((LAS bf16x4*)(vp + 16 * dt)); o[dt] = __builtin_amdgcn_mfma_f32_16x16x16bf16_1k(v0, pf4, o[dt], 0, 0, 0); } }
                const float inv = 1.0f / ls;
                const int token = b * 4096 + (((n * 128 + q0 + c) << (2 * g)) + r);
                bf16_t* od = OG + ((size_t)token * 3 + g) * ATTW + h * 64 + 4 * gq;
#pragma unroll
                for (int dt = 0; dt < 4; ++dt) { u32x2 w; w.x = cvt_pk_bf16(o[dt][0] * inv, o[dt][1] * inv); w.y = cvt_pk_bf16(o[dt][2] * inv, o[dt][3] * inv); *(u32x2*)(od + 16 * dt) = w; }
                if (gq == 0) LSE[((size_t)token * 3 + g) * 8 + h] = (mxs + __builtin_amdgcn_logf(ls)) * 0.6931471805599453f;
            }
            if (e + 1 < 49) AT_WRITE((e + 1) % 3);
            __syncthreads();
            rq[0] = rqn[0]; rq[1] = rqn[1];
        }
#undef AT_LOAD
#undef AT_WRITE
    }
#undef AT_DECODE
}
__device__ __forceinline__ void combine_phase(const bf16_t* OG, const float* LSE, bf16_t* O, int G, int bx) {
    const int tid = opaque_tid();
    for (size_t it = (size_t)bx * NTHR + tid; it < (size_t)M * 64; it += (size_t)G * NTHR) {
        const size_t token = it >> 6; const int h = (int)(it >> 3) & 7, ch = (int)it & 7;
        const float l0 = LSE[(token * 3 + 0) * 8 + h], l1 = LSE[(token * 3 + 1) * 8 + h], l2 = LSE[(token * 3 + 2) * 8 + h];
        const float mx = fmaxf(l0, fmaxf(l1, l2)); float w0 = __expf(l0 - mx), w1 = __expf(l1 - mx), w2 = __expf(l2 - mx); const float inv = 1.0f / (w0 + w1 + w2); w0 *= inv; w1 *= inv; w2 *= inv;
        const u32x4 a = *(const u32x4*)(OG + (token * 3 + 0) * ATTW + h * 64 + ch * 8), b = *(const u32x4*)(OG + (token * 3 + 1) * ATTW + h * 64 + ch * 8), c = *(const u32x4*)(OG + (token * 3 + 2) * ATTW + h * 64 + ch * 8);
        const unsigned aa[4] = {a.x, a.y, a.z, a.w}, bb[4] = {b.x, b.y, b.z, b.w}, cc[4] = {c.x, c.y, c.z, c.w}; unsigned o[4];
#pragma unroll
        for (int j = 0; j < 4; ++j) o[j] = cvt_pk_bf16(w0 * bf_lo(aa[j]) + w1 * bf_lo(bb[j]) + w2 * bf_lo(cc[j]), w0 * bf_hi(aa[j]) + w1 * bf_hi(bb[j]) + w2 * bf_hi(cc[j]));
        *(u32x4*)(O + token * ATTW + h * 64 + ch * 8) = (u32x4){o[0], o[1], o[2], o[3]};
    }
}

__global__ void __launch_bounds__(NTHR, 2) mk_fwd(Params p) {
    extern __shared__ __attribute__((aligned(16))) unsigned char lds_raw[];
    LAS unsigned char* lds = (LAS unsigned char*)lds_raw;
    constexpr int G = NWG; const int bx = blockIdx.x;
    unsigned char* ws = p.ws;
    volatile LAS unsigned* MISC = (volatile LAS unsigned*)(lds + LDS_MISC);
    if (threadIdx.x < 4) MISC[threadIdx.x] = 0u;
    __syncthreads();
    XcdBarrier bar = xcd_barrier_post((unsigned*)(ws + WS_CTL) + CW_BAR, MISC);
    int pc = 0;
#define PH_IF if (pc >= p.lo && pc < p.hi)
#define PH_END do { if (pc >= p.lo && pc + 1 < p.hi) xcd_barrier(bar); ++pc; } while (0)
    bf16_t* xa = (bf16_t*)(ws + WS_XA);
    unsigned char* big = ws + WS_BIG;
    const float* ln_g = p.in[IN_LNG]; const float* ln_b = p.in[IN_LNB];

    PH_IF { p0_phase(p, lds, G, opq_i(bx)); } PH_END;

    for (int pr = 0; pr < 2; ++pr) {
        for (int q = 0; q < 2; ++q) {
            const int l = 2 * pr + q;
            bf16_t* ysrc;
            if (pr == 0) {
                PH_IF { Gemm g{xa, (const bf16_t*)(ws + WS_WIN + l * SZ_WIN), D}; DenseOrder S; S.init(M, 3 * D, G, opq_i(bx), 0);
                        EpiCU E{(bf16_t*)(big + BG_CU), (bf16_t*)(big + BG_GB)}; gemm_phase(lds, g, S, E); } PH_END;
                PH_IF { conv_phase((const bf16_t*)(big + BG_CU), (const bf16_t*)(big + BG_GB), (bf16_t*)(big + BG_G), p.in[IN_ACONV] + (size_t)l * 3 * D, G, opq_i(bx)); } PH_END;
                ysrc = (bf16_t*)p.out;
            } else {
                PH_IF { Gemm g{xa, (const bf16_t*)(ws + (q == 0 ? WS_WQKV2 : WS_WQ3)), D}; DenseOrder S; S.init(M, q == 0 ? NQ + NKV : NQ, G, opq_i(bx), 0);
                        EpiQKV E{(bf16_t*)((unsigned char*)p.out + DO_Q), (bf16_t*)(big + BG_K)}; gemm_phase(lds, g, S, E); } PH_END;
                PH_IF { attn_phase(lds, (const bf16_t*)((unsigned char*)p.out + DO_Q), (const bf16_t*)(big + BG_K), (const bf16_t*)(big + BG_V), (bf16_t*)(big + BG_OG), (float*)(big + BG_LSE), G, opq_i(bx)); } PH_END;
                PH_IF { combine_phase((const bf16_t*)(big + BG_OG), (const float*)(big + BG_LSE), (bf16_t*)((unsigned char*)p.out + DO_O), G, opq_i(bx)); } PH_END;
                ysrc = (bf16_t*)(big + BG_YATT);
            }
            PH_IF { Gemm g; if (pr == 0) g = Gemm{(const bf16_t*)(big + BG_G), (const bf16_t*)(ws + WS_WOUT + l * SZ_WOUT), D}; else g = Gemm{(const bf16_t*)((unsigned char*)p.out + DO_O), (const bf16_t*)(ws + WS_WO + q * SZ_WO), ATTW};
                    DenseOrder S; S.init(M, D, G, opq_i(bx), 0); EpiResid E{ysrc, xa}; gemm_phase(lds, g, S, E); } PH_END;
            if (q == 0) { PH_IF { ln_phase<0>(p, lds, ysrc, ln_g + (size_t)(l * 2) * D, ln_b + (size_t)(l * 2) * D, nullptr, G, opq_i(bx)); } PH_END; }
            else        { PH_IF { ln_phase<1>(p, lds, ysrc, ln_g + (size_t)(l * 2) * D, ln_b + (size_t)(l * 2) * D, p.in[IN_MR] + (size_t)pr * D * NE, G, opq_i(bx)); } PH_END; }
            if (q == 0) {
                for (int hf = 0; hf < 2; ++hf) {
                    PH_IF { Gemm g{xa + (size_t)hf * (M / 2) * D, (const bf16_t*)(ws + WS_WGU + pr * SZ_WGU), D}; DenseOrder S; S.init(M / 2, 2 * DFF, G, opq_i(bx), 0);
                            EpiSwiGLU E{(bf16_t*)(big + BG_HH), DFF}; gemm_phase(lds, g, S, E); } PH_END;
                    PH_IF { Gemm g{(const bf16_t*)(big + BG_HH), (const bf16_t*)(ws + WS_WDN + pr * SZ_WDN), DFF}; DenseOrder S; S.init(M / 2, D, G, opq_i(bx), hf * (M / 2));
                            EpiResid E{(bf16_t*)p.out, xa}; gemm_phase(lds, g, S, E); } PH_END;
                }
                PH_IF { ln_phase<0>(p, lds, (const bf16_t*)p.out, ln_g + (size_t)(l * 2 + 1) * D, ln_b + (size_t)(l * 2 + 1) * D, nullptr, G, opq_i(bx)); } PH_END;
            } else {
                PH_IF { scatter_phase(p, lds, G, opq_i(bx)); } PH_END;
                for (int cch = 0; cch < NCHUNK; ++cch) {
                    PH_IF { const int T = __builtin_amdgcn_readfirstlane(ld_agent((const int*)(ws + CTL_META))); const int t0 = cch * CH_TILES; int nt = T - t0; const int cap = (cch == NCHUNK - 1) ? CH_LAST : CH_TILES; nt = nt < 0 ? 0 : (nt > cap ? cap : nt);
                            const int row0c = moe_tab_to_lds((const int*)(ws + CTL_TAB), t0, nt, (LAS int*)(lds + LDS_TAB));
                            Gemm g{xa, (const bf16_t*)(ws + WS_WM), D}; MoeOrder<true> S{(const int*)(ws + WS_ROUTE + RT_SLOTT), (const LAS int*)(lds + LDS_TAB), nt, 2 * DEX / BM, G, opq_i(bx), row0c, 2 * DEX, 0};
                            EpiSwiGLU E{(bf16_t*)(big + BG_HC), DEX}; gemm_phase(lds, g, S, E); } PH_END;
                    PH_IF { const int T = __builtin_amdgcn_readfirstlane(ld_agent((const int*)(ws + CTL_META))); const int t0 = cch * CH_TILES; int nt = T - t0; const int cap = (cch == NCHUNK - 1) ? CH_LAST : CH_TILES; nt = nt < 0 ? 0 : (nt > cap ? cap : nt);
                            const int row0c = moe_tab_to_lds((const int*)(ws + CTL_TAB), t0, nt, (LAS int*)(lds + LDS_TAB));
                            Gemm g{(const bf16_t*)(big + BG_HC), (const bf16_t*)(ws + WS_WM + SZ_WMGU), DEX}; MoeOrder<false> S{nullptr, (const LAS int*)(lds + LDS_TAB), nt, D / BM, G, opq_i(bx), row0c, D, 1};
                            EpiMoeDown E{(bf16_t*)(big + BG_Y2), (const int*)(ws + WS_ROUTE + RT_SLOTT), (const float*)(ws + WS_ROUTE + RT_SLOTG)}; gemm_phase(lds, g, S, E); } PH_END;
                }
                if (l == 1) { PH_IF { ln_phase<2>(p, lds, nullptr, ln_g + (size_t)(l * 2 + 1) * D, ln_b + (size_t)(l * 2 + 1) * D, nullptr, G, opq_i(bx));
                                      __syncthreads();
                                      const int t2 = opaque_tid(), wave2 = __builtin_amdgcn_readfirstlane(t2 >> 6); LAS float* scr = (LAS float*)(lds + wave2 * TR_WAVE_BYTES);
                                      tr_moe(opq_i(bx) * 8 + wave2, G * 8, p.in[IN_MG] + (size_t)NE * D * DEX, p.in[IN_MU] + (size_t)NE * D * DEX, p.in[IN_MD] + (size_t)NE * DEX * D, ws, scr, t2 & 63); } PH_END; }
                else        { PH_IF { ln_phase<3>(p, lds, nullptr, ln_g + (size_t)(l * 2 + 1) * D, ln_b + (size_t)(l * 2 + 1) * D, nullptr, G, opq_i(bx)); } PH_END; }
            }
        }
    }
#undef PH_IF
#undef PH_END
}
constexpr int NPHASE = 49;

#if MK_DEBUG
enum { K_P0 = 0, K_GIN, K_CONV, K_RESA, K_LN0, K_LN1, K_GU, K_DN, K_LNF, K_SCAT, K_MGU, K_MDN, K_LNM, K_QKV, K_ATT, K_COMB, K_RESB };
__device__ __forceinline__ float bf2f(bf16_t v) { return __uint_as_float((unsigned)v << 16); }
__device__ float dot_a(const bf16_t* a, const float* W, int ldw, int K, float& nrm) { float s = 0.f, q = 0.f; for (int k = 0; k < K; ++k) { const float t = bf2f(a[k]) * W[(size_t)k * ldw]; s += t; q += t * t; } nrm = sqrtf(q); return s; }
__device__ bool closef(float got, float ref, float nrm) { return fabsf(got - ref) <= 0.02f * fabsf(ref) + 0.02f * nrm + 2e-3f && got == got; }
__device__ unsigned hsh(unsigned x) { x ^= x >> 16; x *= 0x7feb352du; x ^= x >> 15; x *= 0x846ca68bu; x ^= x >> 16; return x; }
__device__ int pick_row(unsigned sid, int nrows) { switch (sid) { case 0: return 0; case 1: return 1; case 2: return 255; case 3: return 256; case 4: return 257; case 5: return nrows - 1; case 6: return nrows - 256; case 7: return nrows / 2 + 127; default: break; } return (int)(hsh(sid * 2u + 1u) % (unsigned)nrows); }
__global__ void mk_check(Params p, int kind, int l, int a0, int pc) {
    const unsigned sid = blockIdx.x * blockDim.x + threadIdx.x; unsigned char* ws = p.ws; unsigned char* big = ws + WS_BIG;
    unsigned* dbg = (unsigned*)(ws + WS_CTL) + CW_DBG; const bf16_t* xa = (const bf16_t*)(ws + WS_XA);
    bool ok = true; float n1, n2;
    if (kind == K_GIN) { const int m = pick_row(sid, M), c = hsh(sid) % D; const float* W = p.in[IN_AWIN] + (size_t)l * D * 3 * D;
        const float rb = dot_a(xa + (size_t)m * D, W + c, 3 * D, D, n1); ok = closef(bf2f(((const bf16_t*)(big + BG_GB))[(size_t)m * D + c]), rb, n1);
        const float rc = dot_a(xa + (size_t)m * D, W + D + c, 3 * D, D, n1), ru = dot_a(xa + (size_t)m * D, W + 2 * D + c, 3 * D, D, n2);
        ok = ok && closef(bf2f(((const bf16_t*)(big + BG_CU))[(size_t)m * D + c]), rc * ru, fabsf(rc) * n2 + fabsf(ru) * n1);
    } else if (kind == K_CONV) { const int m = pick_row(sid, M), c = hsh(sid) % D, s = m & (SEQ - 1); const bf16_t* CU = (const bf16_t*)(big + BG_CU); const float* cw = p.in[IN_ACONV] + (size_t)l * 3 * D;
        float cv = cw[2 * D + c] * bf2f(CU[(size_t)m * D + c]); if (s >= 1) cv += cw[D + c] * bf2f(CU[(size_t)(m - 1) * D + c]); if (s >= 2) cv += cw[c] * bf2f(CU[(size_t)(m - 2) * D + c]);
        const float ref = bf2f(((const bf16_t*)(big + BG_GB))[(size_t)m * D + c]) * cv; ok = closef(bf2f(((const bf16_t*)(big + BG_G))[(size_t)m * D + c]), ref, 0.f);
    } else if (kind == K_RESA) { const int m = pick_row(sid, M), c = hsh(sid) % D; const float ref = ALPHA * bf2f(xa[(size_t)m * D + c]) + dot_a((const bf16_t*)(big + BG_G) + (size_t)m * D, p.in[IN_AWOUT] + (size_t)l * D * D + c, D, D, n1);
        ok = closef(bf2f(((const bf16_t*)p.out)[(size_t)m * D + c]), ref, n1);
    } else if (kind == K_RESB) { const int m = pick_row(sid, M), c = hsh(sid) % D; const float ref = ALPHA * bf2f(xa[(size_t)m * D + c]) + dot_a((const bf16_t*)((unsigned char*)p.out + DO_O) + (size_t)m * ATTW, p.in[IN_BWO] + (size_t)(l - 2) * ATTW * D + c, D, ATTW, n1);
        ok = closef(bf2f(((const bf16_t*)(big + BG_YATT))[(size_t)m * D + c]), ref, n1);
    } else if (kind == K_LN0 || kind == K_LN1 || kind == K_LNF) { const int m = pick_row(sid, M), c = hsh(sid) % D; const bf16_t* Yb = (kind == K_LNF || l < 2) ? (const bf16_t*)p.out : (const bf16_t*)(big + BG_YATT); const int which = (kind == K_LNF) ? 1 : 0;
        const float* gm = p.in[IN_LNG] + (size_t)(l * 2 + which) * D; const float* bt = p.in[IN_LNB] + (size_t)(l * 2 + which) * D;
        float mu = 0.f; for (int k = 0; k < D; ++k) mu += bf2f(Yb[(size_t)m * D + k]); mu /= D; float var = 0.f; for (int k = 0; k < D; ++k) { const float d = bf2f(Yb[(size_t)m * D + k]) - mu; var += d * d; } var /= D; const float rs = 1.0f / sqrtf(var + LN_EPS);
        ok = closef(bf2f(xa[(size_t)m * D + c]), (bf2f(Yb[(size_t)m * D + c]) - mu) * rs * gm[c] + bt[c], 0.f);
        if (kind == K_LN1) { const float* wr = p.in[IN_MR] + (size_t)(l / 2) * D * NE; int b1 = -1, b2 = -1; float v1 = -1e30f, v2 = -1e30f, v3 = -1e30f;
            for (int e = 0; e < 8; ++e) { float a = 0.f; for (int k = 0; k < D; ++k) a += ((bf2f(Yb[(size_t)m * D + k]) - mu) * rs * gm[k] + bt[k]) * wr[k * NE + e];
                if (a > v1) { v3 = v2; v2 = v1; b2 = b1; v1 = a; b1 = e; } else if (a > v2) { v3 = v2; v2 = a; b2 = e; } else if (a > v3) v3 = a; }
            const int e1 = ((const int*)(ws + WS_ROUTE + RT_TOKE))[m * 2], e2 = ((const int*)(ws + WS_ROUTE + RT_TOKE))[m * 2 + 1]; const float g1 = ((const float*)(ws + WS_ROUTE + RT_TOKG))[m * 2], g2 = ((const float*)(ws + WS_ROUTE + RT_TOKG))[m * 2 + 1];
            const bool tie = (v1 - v2 < 1e-3f) || (v2 - v3 < 1e-3f); const float r1 = 1.0f / (1.0f + expf(v2 - v1));
            if (!tie) ok = ok && e1 == b1 && e2 == b2 && fabsf(g1 - r1) < 2e-3f && fabsf(g1 + g2 - 1.0f) < 1e-4f; }
    } else if (kind == K_GU) { const int mr = pick_row(sid, M / 2), f = hsh(sid) % DFF, m = a0 * (M / 2) + mr; const int i = l / 2;
        const float rg = dot_a(xa + (size_t)m * D, p.in[IN_FG] + (size_t)i * D * DFF + f, DFF, D, n1), ru = dot_a(xa + (size_t)m * D, p.in[IN_FU] + (size_t)i * D * DFF + f, DFF, D, n2);
        const float sg = rg / (1.0f + expf(-rg)); ok = closef(bf2f(((const bf16_t*)(big + BG_HH))[(size_t)mr * DFF + f]), sg * ru, fabsf(sg) * n2 + fabsf(ru) * n1);
    } else if (kind == K_DN) { const int mr = pick_row(sid, M / 2), c = hsh(sid) % D, m = a0 * (M / 2) + mr; const int i = l / 2;
        const float ref = ALPHA * bf2f(xa[(size_t)m * D + c]) + dot_a((const bf16_t*)(big + BG_HH) + (size_t)mr * DFF, p.in[IN_FD] + (size_t)i * DFF * D + c, D, DFF, n1); ok = closef(bf2f(((const bf16_t*)p.out)[(size_t)m * D + c]), ref, n1);
    } else if (kind == K_SCAT) { const int* tok_slot = (const int*)(ws + WS_ROUTE + RT_TOKS); const int* slot_tok = (const int*)(ws + WS_ROUTE + RT_SLOTT); const int* tok_e = (const int*)(ws + WS_ROUTE + RT_TOKE); const int* gcnt = (const int*)(ws + CTL_CNT);
        for (int ent = sid; ent < NSLOT; ent += gridDim.x * blockDim.x) { const int slot = tok_slot[ent]; if (slot < 0 || slot >= NSLOT || slot_tok[slot] != ent) ok = false; }
        const int ent = hsh(sid) % NSLOT, slot = tok_slot[ent], e = tok_e[ent]; int s0 = 0, n = 0; for (int x = 0; x < 8; ++x) { int t = 0; for (int w = 0; w < 256; ++w) t += gcnt[w * 8 + x]; if (x < e) s0 += t; if (x == e) n = t; }
        if (slot >= 0 && slot < NSLOT) { if (slot < s0 || slot >= s0 + n) ok = false; const int c = hsh(sid + 77u) % D; if (((const bf16_t*)p.out)[(size_t)slot * D + c] != xa[(size_t)(ent >> 1) * D + c]) ok = false; }
        if (sid == 0) { const int T = ((const int*)(ws + CTL_META))[0]; if (T < 512 || T > 520) ok = false; }
    } else if (kind == K_MGU || kind == K_MDN) { const int* tab = (const int*)(ws + CTL_TAB); const int T = ((const int*)(ws + CTL_META))[0]; const int t0 = a0 * CH_TILES; int nt = T - t0; const int cap = (a0 == NCHUNK - 1) ? CH_LAST : CH_TILES; nt = nt < 0 ? 0 : (nt > cap ? cap : nt);
        if (nt > 0) { const int t = t0 + hsh(sid) % nt, e = tab[4 * t], row0 = tab[4 * t + 1], lo = tab[4 * t + 2], hi = tab[4 * t + 3], row0c = tab[4 * t0 + 1];
            const int r = (sid & 3) == 0 ? lo : ((sid & 3) == 1 ? hi - 1 : lo + hsh(sid + 5u) % (hi - lo)); const int slot = row0 + r; const int i = l / 2;
            const int ent = ((const int*)(ws + WS_ROUTE + RT_SLOTT))[slot]; if (((const int*)(ws + WS_ROUTE + RT_TOKE))[ent] != e) ok = false;
            const bf16_t* hrow = (const bf16_t*)(big + BG_HC) + (size_t)(slot - row0c) * DEX;
            if (kind == K_MGU) { const int f = hsh(sid + 9u) % DEX; const bf16_t* xr = (const bf16_t*)p.out + (size_t)slot * D; const size_t wo = ((size_t)i * NE + e) * D * DEX + f;
                const float rg = dot_a(xr, p.in[IN_MG] + wo, DEX, D, n1), ru = dot_a(xr, p.in[IN_MU] + wo, DEX, D, n2); const float sg = rg / (1.0f + expf(-rg));
                ok = ok && closef(bf2f(hrow[f]), sg * ru, fabsf(sg) * n2 + fabsf(ru) * n1);
            } else { const int c = hsh(sid + 9u) % D; const float gt = ((const float*)(ws + WS_ROUTE + RT_SLOTG))[slot];
                const float ref = gt * dot_a(hrow, p.in[IN_MD] + ((size_t)i * NE + e) * DEX * D + c, D, DEX, n1);
                ok = ok && closef(bf2f(((const bf16_t*)(big + BG_Y2))[((size_t)(ent & 1) * M + (ent >> 1)) * D + c]), ref, gt * n1); } }
    } else if (kind == K_QKV) { const int m = pick_row(sid, M), ncol = (l == 2) ? NQ + NKV : NQ, c = hsh(sid) % ncol; float ref; bf16_t got;
        if (c < NQ) { ref = dot_a(xa + (size_t)m * D, p.in[IN_BWQ] + (size_t)(l - 2) * D * NQ + c, NQ, D, n1); got = ((const bf16_t*)((unsigned char*)p.out + DO_Q))[resid_off(m, c >> 9, (c >> 6) & 7, c & 63)]; }
        else { const int c2 = c - NQ; ref = dot_a(xa + (size_t)m * D, p.in[IN_KVW] + c2, NKV, D, n1); got = ((const bf16_t*)(big + (((c2 >> 9) & 1) ? BG_V : BG_K)))[resid_off(m, c2 >> 10, (c2 >> 6) & 7, c2 & 63)]; }
        ok = closef(bf2f(got), ref, n1);
    } else if (kind == K_ATT) { const int m = pick_row(sid, M), g = hsh(sid) % 3, h = hsh(sid + 3u) % 8, d = 1 << (2 * g), b = m >> 12, s = m & 4095; const bf16_t* Q = (const bf16_t*)((unsigned char*)p.out + DO_Q); const bf16_t* K = (const bf16_t*)(big + BG_K); const bf16_t* V = (const bf16_t*)(big + BG_V);
        float mx = -1e30f; const int ev = hsh(sid + 11u) % 64; float den = 0.f, o = 0.f;
        for (int pass = 0; pass < 2; ++pass) for (int j = 0; j <= 128; ++j) { const int sk = s - j * d; if (sk < 0) break; float a = 0.f; for (int e = 0; e < 64; ++e) a += bf2f(Q[resid_off(m, g, h, e)]) * bf2f(K[resid_off(b * 4096 + sk, g, h, e)]); a *= 0.125f;
            if (pass == 0) mx = fmaxf(mx, a); else { const float pe = expf(a - mx); den += pe; o += pe * bf2f(V[resid_off(b * 4096 + sk, g, h, ev)]); } }
        o /= den; const int e = ev;
        ok = closef(bf2f(((const bf16_t*)(big + BG_OG))[((size_t)m * 3 + g) * ATTW + h * 64 + e]), o, 0.02f) && closef(((const float*)(big + BG_LSE))[((size_t)m * 3 + g) * 8 + h], mx + logf(den), 0.05f);
    } else if (kind == K_COMB) { const int m = pick_row(sid, M), h = hsh(sid) % 8, e = hsh(sid + 3u) % 64; const float* L = (const float*)(big + BG_LSE) + (size_t)m * 24 + h; const float mx = fmaxf(L[0], fmaxf(L[8], L[16]));
        const float w0 = expf(L[0] - mx), w1 = expf(L[8] - mx), w2 = expf(L[16] - mx); const bf16_t* og = (const bf16_t*)(big + BG_OG) + (size_t)m * 3 * ATTW + h * 64 + e;
        ok = closef(bf2f(((const bf16_t*)((unsigned char*)p.out + DO_O))[(size_t)m * ATTW + h * 64 + e]), (w0 * bf2f(og[0]) + w1 * bf2f(og[ATTW]) + w2 * bf2f(og[2 * ATTW])) / (w0 + w1 + w2), 0.02f);
    }
    if (!ok) atomicAdd(&dbg[1 + pc], 1u);
    if (sid == 0 && ((const unsigned*)(ws + WS_CTL))[CW_BAR + XB_TMO] != 0u) atomicAdd(&dbg[1 + 98], 1u);
}
__global__ void mk_report(float* out, const unsigned* dbg) {
    int code = 0; for (int pc = 0; pc < 99 && code == 0; ++pc) if (dbg[1 + pc] > (pc == 98 ? 0u : 12u)) code = pc + 1;
    if (code == 0) return;
    const float V = sqrtf(100.0f * (float)code);
    for (size_t i = (size_t)blockIdx.x * blockDim.x + threadIdx.x; i < (size_t)M * D; i += (size_t)gridDim.x * blockDim.x) out[i] = V;
}
#endif
}

extern "C" void kernel_launch(void* const* d_in, const int* in_sizes, int n_in, void* d_out, int out_size, void* d_ws, size_t ws_size, hipStream_t stream) {
    using namespace mk;
    static int grid = 0;
    if (grid == 0) {
        if (n_in != 16 || in_sizes[0] != M * D || out_size != M * D || ws_size < WS_NEED) { fprintf(stderr, "kernel_launch: unexpected shapes (n_in %d, in0 %d, out %d, ws %zu, need %zu)\n", n_in, n_in > 0 ? in_sizes[0] : -1, out_size, ws_size, (size_t)WS_NEED); grid = -1; return; }
        int dev = 0, cus = 0, per_cu = 0;
        if (hipGetDevice(&dev) != hipSuccess || hipDeviceGetAttribute(&cus, hipDeviceAttributeMultiprocessorCount, dev) != hipSuccess) { grid = -1; return; }
        if (hipFuncSetAttribute((const void*)mk_fwd, hipFuncAttributeMaxDynamicSharedMemorySize, LDS_BYTES) != hipSuccess) { fprintf(stderr, "kernel_launch: hipFuncSetAttribute failed\n"); grid = -1; return; }
        if (hipOccupancyMaxActiveBlocksPerMultiprocessor(&per_cu, (const void*)mk_fwd, NTHR, LDS_BYTES) != hipSuccess || per_cu < 1) fprintf(stderr, "kernel_launch: occupancy query reports %d\n", per_cu);
        (void)hipGetLastError();
        if (cus != NWG) { fprintf(stderr, "kernel_launch: built for %d CUs, device has %d\n", NWG, cus); grid = -1; return; }
        grid = NWG;
    }
    if (grid < 0) return;
    (void)hipMemsetAsync((char*)d_ws + WS_CTL, 0, CTL_ZERO_BYTES, stream);
    Params p{};
    for (int i = 0; i < 16; ++i) p.in[i] = (const float*)d_in[i];
    p.out = (float*)d_out; p.ws = (unsigned char*)d_ws; p.lo = 0; p.hi = NPHASE;
#if !MK_DEBUG
    hipLaunchKernelGGL(mk_fwd, dim3(grid), dim3(NTHR), LDS_BYTES, stream, p);
#else
    int pc = 0;
    auto run = [&](int kind, int l, int a0) { p.lo = pc; p.hi = pc + 1; hipLaunchKernelGGL(mk_fwd, dim3(grid), dim3(NTHR), LDS_BYTES, stream, p);
        if (kind != K_P0 && kind != K_LNM) hipLaunchKernelGGL(mk_check, dim3(4), dim3(256), 0, stream, p, kind, l, a0, pc); ++pc; };
    run(K_P0, 0, 0);
    for (int pr = 0; pr < 2; ++pr) for (int q = 0; q < 2; ++q) { const int l = 2 * pr + q;
        if (pr == 0) { run(K_GIN, l, 0); run(K_CONV, l, 0); run(K_RESA, l, 0); } else { run(K_QKV, l, 0); run(K_ATT, l, 0); run(K_COMB, l, 0); run(K_RESB, l, 0); }
        run(q == 0 ? K_LN0 : K_LN1, l, 0);
        if (q == 0) { for (int hf = 0; hf < 2; ++hf) { run(K_GU, l, hf); run(K_DN, l, hf); } run(K_LNF, l, 0); }
        else { run(K_SCAT, l, 0); for (int c = 0; c < NCHUNK; ++c) { run(K_MGU, l, c); run(K_MDN, l, c); } run(K_LNM, l, 0); } }
    if (pc != NPHASE) fprintf(stderr, "kernel_launch: debug phase enumeration mismatch %d\n", pc);
    hipLaunchKernelGGL(mk_report, dim3(1024), dim3(256), 0, stream, (float*)d_out, (const unsigned*)((char*)d_ws + WS_CTL) + CW_DBG);
#endif
}
```

```cpp
#include <hip/hip_runtime.h>
#include <cstdio>
#include <cstdint>

#ifndef MK_DEBUG
#define MK_DEBUG 0
#endif

namespace mk {
#define LAS __attribute__((address_space(3)))
typedef unsigned short bf16_t;
typedef short bf16x8 __attribute__((ext_vector_type(8)));
typedef short bf16x4 __attribute__((ext_vector_type(4)));
typedef float f32x4 __attribute__((ext_vector_type(4)));
typedef unsigned u32x4 __attribute__((ext_vector_type(4)));
typedef unsigned u32x2 __attribute__((ext_vector_type(2)));

constexpr int NB = 16, SEQ = 4096, D = 1024, M = NB * SEQ;
constexpr int DFF = 2816, NE = 8, DEX = 3584, ATTW = 512, NQ = 3 * ATTW, NKV = 6 * ATTW;
constexpr float ALPHA = 1.6817928305074292f;
constexpr float LN_EPS = 1e-5f;
constexpr int NWG = 256, NTHR = 512;
constexpr int NSLOT = 2 * M;
constexpr int CH_TILES = 128, NCHUNK = 4, CH_LAST = 136, TILE_CAP = 640;

constexpr size_t MiB = (size_t)1 << 20;
constexpr size_t WS_CTL = 0;
constexpr size_t CTL_ZERO_BYTES = 64 * 1024;
constexpr int CW_BAR = 1024;
constexpr int CW_DBG = 8192;
constexpr size_t CTL_CNT = 64 * 1024;
constexpr size_t CTL_TAB = 80 * 1024;
constexpr size_t CTL_META = 96 * 1024;
constexpr size_t WS_SMALL = 1 * MiB;
constexpr size_t WS_WIN = WS_SMALL, WS_WOUT = WS_SMALL + 12 * MiB, WS_WQKV2 = WS_SMALL + 16 * MiB, WS_WQ3 = WS_SMALL + 25 * MiB, WS_WO = WS_SMALL + 28 * MiB,
                 WS_WGU = WS_SMALL + 30 * MiB, WS_WDN = WS_SMALL + 52 * MiB;
constexpr size_t SZ_WIN = (size_t)3 * D * D * 2, SZ_WOUT = (size_t)D * D * 2, SZ_WO = (size_t)D * ATTW * 2, SZ_WGU = (size_t)2 * DFF * D * 2, SZ_WDN = (size_t)D * DFF * 2;
constexpr size_t WS_WM = 65 * MiB;
constexpr size_t SZ_WMGU = (size_t)NE * 2 * DEX * D * 2;
constexpr size_t WS_XA = 233 * MiB;
constexpr size_t WS_ROUTE = 361 * MiB;
constexpr size_t RT_TOKE = 0, RT_TOKG = 512 * 1024, RT_TOKR = 1024 * 1024, RT_SLOTT = 1536 * 1024, RT_SLOTG = 2048 * 1024 + 4096, RT_TOKS = 2560 * 1024 + 8192;
constexpr size_t WS_BIG = 365 * MiB;
constexpr size_t BG_CU = 0, BG_GB = 128 * MiB, BG_G = 256 * MiB;
constexpr size_t BG_K = 0, BG_V = 192 * MiB  , BG_OG = 384 * MiB, BG_LSE = 576 * MiB, BG_YATT = 384 * MiB;
constexpr size_t BG_HH = 384 * MiB;
constexpr size_t BG_HC = 0, BG_Y2 = 238 * MiB;
constexpr int XROW = 73728;
static_assert((size_t)XROW * DEX * 2 >= 494 * MiB && (size_t)(XROW + 8 * 256) * DEX * 2 <= 640 * MiB, "extra-tile region");
constexpr size_t WS_NEED = WS_BIG + 640 * MiB;
constexpr size_t DO_Q = 0, DO_O = 192 * MiB;

typedef float f32x2c __attribute__((ext_vector_type(2)));
typedef __bf16 bf16x2c __attribute__((ext_vector_type(2)));
__device__ __forceinline__ unsigned cvt_pk_bf16(float lo, float hi) { const f32x2c v = {lo, hi}; return __builtin_bit_cast(unsigned, __builtin_convertvector(v, bf16x2c)); }
__device__ __forceinline__ float bf_lo(unsigned w) { return __uint_as_float(w << 16); }
__device__ __forceinline__ float bf_hi(unsigned w) { return __uint_as_float(w & 0xffff0000u); }
__device__ __forceinline__ int ld_agent(const int* p) { return __hip_atomic_load(p, __ATOMIC_RELAXED, __HIP_MEMORY_SCOPE_AGENT); }
__device__ __forceinline__ int opaque_tid() { int t = threadIdx.x; asm volatile("" : "+v"(t)); return t; }
__device__ __forceinline__ int opq_i(int v) { asm volatile("" : "+s"(v)); return v; }
template <class T> __device__ __forceinline__ T* opq(T* p) { asm volatile("" : "+s"(p)); return p; }
__device__ __forceinline__ float wave_sum(float v) {
    v += __builtin_bit_cast(float, __builtin_amdgcn_update_dpp(0, __builtin_bit_cast(int, v), 0xB1, 0xf, 0xf, true));
    v += __builtin_bit_cast(float, __builtin_amdgcn_update_dpp(0, __builtin_bit_cast(int, v), 0x4E, 0xf, 0xf, true));
    v += __builtin_bit_cast(float, __builtin_amdgcn_update_dpp(0, __builtin_bit_cast(int, v), 0x141, 0xf, 0xf, true));
    v += __builtin_bit_cast(float, __builtin_amdgcn_update_dpp(0, __builtin_bit_cast(int, v), 0x140, 0xf, 0xf, true));
    v += __builtin_bit_cast(float, __builtin_amdgcn_update_dpp(0, __builtin_bit_cast(int, v), 0x142, 0xa, 0xf, false));
    v += __builtin_bit_cast(float, __builtin_amdgcn_update_dpp(0, __builtin_bit_cast(int, v), 0x143, 0xc, 0xf, false));
    return __builtin_bit_cast(float, __builtin_amdgcn_readlane(__builtin_bit_cast(int, v), 63));
}
__device__ __forceinline__ float shx(float v, int o, int lane) { return __builtin_bit_cast(float, __builtin_amdgcn_ds_bpermute((lane ^ o) << 2, __builtin_bit_cast(int, v))); }

#define XB_TMO      128
#define XB_XCNT(j)  (256  + 64 * (j))
#define XB_XSUB(j)  (1280 + 64 * (j))
#define XB_XGEN(j)  (2304 + 64 * (j))
#define XB_TOP      3328
#define XB_TOPGEN   3392
#define XCD_BAR_WORDS 3456
#define XB_SPIN_CAP (1u << 18)
__device__ __forceinline__ unsigned xb_ld(unsigned* p)              { return __hip_atomic_load(p, __ATOMIC_RELAXED, __HIP_MEMORY_SCOPE_AGENT); }
__device__ __forceinline__ unsigned xb_add(unsigned* p, unsigned v) { return __hip_atomic_fetch_add(p, v, __ATOMIC_RELAXED, __HIP_MEMORY_SCOPE_AGENT); }
__device__ __forceinline__ unsigned xb_xcc_id() { return (unsigned)__builtin_amdgcn_s_getreg((3 << 11) | 20) & 0xFu; }
#define XB_SPIN(cond, bar) do { unsigned _sp = 0; while (cond) { __builtin_amdgcn_s_sleep(1); \
    if ((++_sp & 255u) == 0u) { if (xb_ld(&(bar)[XB_TMO])) break; if (_sp > XB_SPIN_CAP) { atomicAdd(&(bar)[XB_TMO], 1u); break; } } } } while (0)
struct XcdBarrier { unsigned* bar; unsigned x; volatile LAS unsigned* st; };
__device__ __forceinline__ XcdBarrier xcd_barrier_post(unsigned* bar, volatile LAS unsigned* st) {
    XcdBarrier b; b.bar = bar; b.x = xb_xcc_id(); b.st = st;
    if (threadIdx.x == 0) (void)xb_add(&bar[XB_XCNT(b.x)], 1u);
    return b;
}
__device__ __forceinline__ void xcd_barrier_complete(unsigned* bar, unsigned x, unsigned& nloc, unsigned& nx) {
    const unsigned G = gridDim.x * gridDim.y * gridDim.z;
    unsigned sum, cnt, mine, sp = 0u;
    for (;;) {
        sum = 0u; cnt = 0u; mine = 0u;
#pragma unroll
        for (unsigned j = 0; j < 16; ++j) { const unsigned c = xb_ld(&bar[XB_XCNT(j)]); sum += c; cnt += (c > 0u) ? 1u : 0u; mine = (j == x) ? c : mine; }
        if (sum == G) break;
        __builtin_amdgcn_s_sleep(1);
        if ((++sp & 255u) == 0u) { if (xb_ld(&bar[XB_TMO])) break; if (sp > XB_SPIN_CAP) { atomicAdd(&bar[XB_TMO], 1u); break; } }
    }
    nloc = mine > 0u ? mine : 1u; nx = cnt > 0u ? cnt : 1u;
}
__device__ __forceinline__ void xcd_barrier(const XcdBarrier& b) {
    asm volatile("s_waitcnt vmcnt(0)" ::: "memory");
    __syncthreads();
    if (threadIdx.x == 0) {
        unsigned* bar = b.bar;
        __builtin_amdgcn_s_waitcnt(0);
        unsigned nloc = b.st[0], nx = b.st[1];
        if (nloc == 0u) { xcd_barrier_complete(bar, b.x, nloc, nx); b.st[0] = nloc; b.st[1] = nx; }
        const unsigned old = xb_add(&bar[XB_XSUB(b.x)], 1u);
        const unsigned gen = old / nloc;
        if (old + 1u == (gen + 1u) * nloc) {
            __builtin_amdgcn_fence(__ATOMIC_RELEASE, "agent");
            asm volatile("s_waitcnt vmcnt(0)" ::: "memory");
            const unsigned og = xb_add(&bar[XB_TOP], 1u);
            const unsigned tg = og / nx;
            if (og + 1u == (tg + 1u) * nx) xb_add(&bar[XB_TOPGEN], 1u);
            else XB_SPIN(xb_ld(&bar[XB_TOPGEN]) == tg, bar);
            __builtin_amdgcn_fence(__ATOMIC_ACQUIRE, "agent");
            xb_add(&bar[XB_XGEN(b.x)], 1u);
            asm volatile("s_waitcnt vmcnt(0)" ::: "memory");
        } else {
            XB_SPIN(xb_ld(&bar[XB_XGEN(b.x)]) == gen, bar);
            __builtin_amdgcn_fence(__ATOMIC_ACQUIRE, "agent");
            asm volatile("s_waitcnt vmcnt(0)" ::: "memory");
        }
    }
    __syncthreads();
}

#ifndef MOE_WGM
#define MOE_WGM 8
#endif
constexpr int BM = 256, BK = 64, HALF = 128, HTB = HALF * BK * 2, STAGE_BYTES = 8 * HTB, NXCD = 8, WGM = 4;
__device__ __forceinline__ int lds_byte(int r, int c) { const int st = (r >> 4) * 2 + (c >> 5), rr = r & 15, cc = c & 31, ob = rr * 64 + cc * 2; return st * 1024 + (ob ^ (((ob >> 9) & 1) << 5)); }
__device__ __forceinline__ void stage_rc(int b, int& R, int& C) { const int st = b / 1024, sb = b % 1024, swz = sb ^ (((sb >> 9) & 1) << 5); R = (st >> 1) * 16 + swz / 64; C = (st & 1) * 32 + (swz % 64) / 2; }
__device__ __forceinline__ int perm32(int rho) { const int n = rho >> 4, i = rho & 15; return 8 * (i >> 2) + 4 * n + (i & 3); }

struct Unit { int arow, brow, orow, pn, lo, hi; };
struct Gemm { const bf16_t* A; const bf16_t* Bt; int K; };

struct DenseOrder {
    static constexpr bool GATHER = false; __device__ __forceinline__ const int* gidx() const { return nullptr; }
    int nM, nN, nwg, G, c, row_base;
    __device__ __forceinline__ void init(int Mrows, int N, int G_, int c_, int row_base_) { nM = Mrows / BM; nN = N / BM; nwg = nM * nN; G = G_; c = c_; row_base = row_base_; }
    __device__ __forceinline__ bool next(int i, Unit& u) const {
        const long L = (long)i * G + c; if (L >= nwg) return false;
        int wgid = (int)L; { const int q = nwg / NXCD, r = nwg % NXCD, xcd = wgid % NXCD, off = wgid / NXCD; wgid = (xcd < r ? xcd * (q + 1) : r * (q + 1) + (xcd - r) * q) + off; }
        const int nig = WGM * nN, gid = wgid / nig, fm = gid * WGM, gsz = (nM - fm) < WGM ? (nM - fm) : WGM;
        const int pm = fm + ((wgid % nig) % gsz), pn = (wgid % nig) / gsz;
        u.arow = pm * BM; u.brow = pn * BM; u.orow = row_base + pm * BM; u.pn = pn; u.lo = 0; u.hi = BM; return true;
    }
};
template <bool GA>
struct MoeOrder {
    static constexpr bool GATHER = GA; const int* gix; __device__ __forceinline__ const int* gidx() const { return gix; }
    const LAS int* tab; int nt, nN, G, c, row0c, brows, down;
    int xt, row0x;
    int H;
    __device__ __forceinline__ bool next(int i, Unit& u) const {
        const int nwg = nt * nN; int L0 = i * G + c;
        if (H > 0) { const int NR = nwg / G;
            if (c < H) { if (i >= NR - 3) return false; }
            else if (i >= NR) { const int cp = c - H; if (i > NR || cp >= 3 * H) return false; const int q = (cp >= H ? 1 : 0) + (cp >= 2 * H ? 1 : 0); L0 = (NR - 3 + q) * G + (cp - q * H); } }
        if (L0 >= nwg) return false;
        int L = L0; { const int q = nwg / NXCD, r = nwg % NXCD, xcd = L % NXCD, off = L / NXCD; L = (xcd < r ? xcd * (q + 1) : r * (q + 1) + (xcd - r) * q) + off; }
        constexpr int MG = MOE_WGM; const int nig = MG * nN, gid = L / nig, fm = gid * MG, gsz = (nt - fm) < MG ? (nt - fm) : MG, w = L % nig;
        const int tl = fm + w % gsz, pn = w / gsz;
        const LAS int* tt = tab + 4 * tl;
        const int e = __builtin_amdgcn_readfirstlane(tt[0]), row0 = __builtin_amdgcn_readfirstlane(tt[1]);
        u.lo = __builtin_amdgcn_readfirstlane(tt[2]); u.hi = __builtin_amdgcn_readfirstlane(tt[3]);
        u.pn = pn; u.brow = e * brows + pn * BM;
        const int rc = tl >= xt ? row0x : row0c;
        if (!down) { u.arow = row0; u.orow = row0 - rc; } else { u.arow = row0 - rc; u.orow = row0; }
        return true;
    }
};

#define EPI_ROWS(ai, m) ((ai) * HALF + wr * 64 + (m) * 16 + fr)
__device__ __forceinline__ u32x4 pack8(const f32x4& a, const f32x4& b) { u32x4 w; w.x = cvt_pk_bf16(a[0], a[1]); w.y = cvt_pk_bf16(a[2], a[3]); w.z = cvt_pk_bf16(b[0], b[1]); w.w = cvt_pk_bf16(b[2], b[3]); return w; }
__device__ __forceinline__ float silu(float x) { return x * __builtin_amdgcn_rcpf(1.0f + __builtin_amdgcn_exp2f(-1.4426950408889634f * x)); }

struct EpiResid {
    bf16_t* Y; const bf16_t* X;
    __device__ __forceinline__ void operator()(const f32x4 (&acc)[2][2][4][2], const Unit& u, int wr, int wc, int fr, int fq) const {
        const int col0 = u.pn * BM + wc * 32 + 8 * fq;
#pragma unroll
        for (int ai = 0; ai < 2; ++ai)
#pragma unroll
            for (int m = 0; m < 4; ++m) { const size_t off = (size_t)(u.orow + EPI_ROWS(ai, m)) * D + col0;
#pragma unroll
                for (int bj = 0; bj < 2; ++bj) { const u32x4 xv = *(const u32x4*)(X + off + bj * HALF); const f32x4 a0 = acc[ai][bj][m][0], a1 = acc[ai][bj][m][1];
                    f32x4 o0, o1; o0[0] = ALPHA * bf_lo(xv.x) + a0[0]; o0[1] = ALPHA * bf_hi(xv.x) + a0[1]; o0[2] = ALPHA * bf_lo(xv.y) + a0[2]; o0[3] = ALPHA * bf_hi(xv.y) + a0[3];
                    o1[0] = ALPHA * bf_lo(xv.z) + a1[0]; o1[1] = ALPHA * bf_hi(xv.z) + a1[1]; o1[2] = ALPHA * bf_lo(xv.w) + a1[2]; o1[3] = ALPHA * bf_hi(xv.w) + a1[3];
                    *(u32x4*)(Y + off + bj * HALF) = pack8(o0, o1); }
                asm volatile("" ::: "memory"); }
    }
};
struct EpiSwiGLU {
    bf16_t* H; int ldh;
    __device__ __forceinline__ void operator()(const f32x4 (&acc)[2][2][4][2], const Unit& u, int wr, int wc, int fr, int fq) const {
        const int col0 = u.pn * HALF + wc * 32 + 8 * fq;
#pragma unroll
        for (int ai = 0; ai < 2; ++ai)
#pragma unroll
            for (int m = 0; m < 4; ++m) { const int r = EPI_ROWS(ai, m);
                if (r >= u.lo && r < u.hi) { f32x4 h0, h1;
#pragma unroll
                    for (int j = 0; j < 4; ++j) { h0[j] = silu(acc[ai][0][m][0][j]) * acc[ai][1][m][0][j]; h1[j] = silu(acc[ai][0][m][1][j]) * acc[ai][1][m][1][j]; }
                    *(u32x4*)(H + (size_t)(u.orow + r) * ldh + col0) = pack8(h0, h1); } }
    }
};
struct EpiCU {
    bf16_t* CU; bf16_t* GB;
    __device__ __forceinline__ void operator()(const f32x4 (&acc)[2][2][4][2], const Unit& u, int wr, int wc, int fr, int fq) const {
        if (u.pn < 8) { const int col0 = u.pn * HALF + wc * 32 + 8 * fq;
#pragma unroll
            for (int ai = 0; ai < 2; ++ai)
#pragma unroll
                for (int m = 0; m < 4; ++m) { const f32x4 c0 = acc[ai][0][m][0] * acc[ai][1][m][0], c1 = acc[ai][0][m][1] * acc[ai][1][m][1];
                    *(u32x4*)(CU + (size_t)(u.orow + EPI_ROWS(ai, m)) * D + col0) = pack8(c0, c1); }
        } else { const int col0 = (u.pn - 8) * BM + wc * 32 + 8 * fq;
#pragma unroll
            for (int ai = 0; ai < 2; ++ai)
#pragma unroll
                for (int m = 0; m < 4; ++m)
#pragma unroll
                    for (int bj = 0; bj < 2; ++bj) *(u32x4*)(GB + (size_t)(u.orow + EPI_ROWS(ai, m)) * D + col0 + bj * HALF) = pack8(acc[ai][bj][m][0], acc[ai][bj][m][1]);
        }
    }
};
__device__ __forceinline__ size_t resid_off(int token, int g, int h, int e) {
    const int b = token >> 12, s = token & 4095, sh = 2 * g, rr = s & ((1 << sh) - 1), i = s >> sh, L = 4096 >> sh;
    return ((size_t)((b * 3 + g) * 8 + h) * 4096 + (size_t)rr * L + i) * 64 + e;
}
struct EpiQKV {
    bf16_t *Q, *KV;
    __device__ __forceinline__ void operator()(const f32x4 (&acc)[2][2][4][2], const Unit& u, int wr, int wc, int fr, int fq) const {
#pragma unroll
        for (int bj = 0; bj < 2; ++bj) { const int cw = u.pn * BM + bj * HALF + wc * 32;
            const bool isq = cw < NQ; const int c2 = cw - NQ;
            const int g = isq ? (cw >> 9) : (c2 >> 10), h = isq ? ((cw >> 6) & 7) : ((c2 >> 6) & 7);
            bf16_t* dst = KV + (size_t)((c2 >> 9) & 1) * ((size_t)M * 1536); if (isq) dst = Q;
            const int e0 = (cw & 63) + 8 * fq, sh = 2 * g, L = 4096 >> sh;
#pragma unroll
            for (int ai = 0; ai < 2; ++ai)
#pragma unroll
                for (int m = 0; m < 4; ++m) { const int token = u.orow + EPI_ROWS(ai, m), b = token >> 12, s = token & 4095, rr = s & ((1 << sh) - 1), i = s >> sh;
                    *(u32x4*)(dst + ((size_t)((b * 3 + g) * 8 + h) * 4096 + (size_t)(rr * L + i)) * 64 + e0) = pack8(acc[ai][bj][m][0], acc[ai][bj][m][1]);
                    asm volatile("" ::: "memory"); }
        }
    }
};
struct EpiMoeDown {
    bf16_t* Y2; const int* slot_tok; const float* slot_gate;
    __device__ __forceinline__ void operator()(const f32x4 (&acc)[2][2][4][2], const Unit& u, int wr, int wc, int fr, int fq) const {
        const int col0 = u.pn * BM + wc * 32 + 8 * fq;
#pragma unroll
        for (int ai = 0; ai < 2; ++ai)
#pragma unroll
            for (int m = 0; m < 4; ++m) { const int r = EPI_ROWS(ai, m);
                if (r >= u.lo && r < u.hi) { const int ent = slot_tok[u.orow + r]; const float gt = slot_gate[u.orow + r];
                    bf16_t* rowp = Y2 + ((size_t)(ent & 1) * M + (ent >> 1)) * D + col0;
#pragma unroll
                    for (int bj = 0; bj < 2; ++bj) *(u32x4*)(rowp + bj * HALF) = pack8(acc[ai][bj][m][0] * gt, acc[ai][bj][m][1] * gt); } }
    }
};

__device__ __forceinline__ int moe_tab_to_lds(const int* gtab, int t0, int nt, LAS int* ltab) {
    const int tid = opaque_tid();
    for (int i = tid; i < 4 * nt; i += NTHR) ltab[i] = ld_agent(gtab + 4 * t0 + i);
    const int row0c = __builtin_amdgcn_readfirstlane(ld_agent(gtab + 4 * t0 + 1));
    __syncthreads();
    return row0c;
}
template <class Epi, class Sched>
__device__ __forceinline__ void gemm_phase(LAS unsigned char* lds, const Gemm g, const Sched& S, const Epi& E) {
    const int tid = opaque_tid(), wid = __builtin_amdgcn_readfirstlane(tid >> 6), lane = tid & 63, wr = wid >> 2, wc = wid & 3, fr = lane & 15, fq = lane >> 4;
    const int K = g.K, nt = K / BK;
    unsigned voffA[2], voffB[2];
#pragma unroll
    for (int i = 0; i < 2; ++i) { int R, C; stage_rc(tid * 16 + i * 8192, R, C); const int Rb = (R & ~31) + perm32(R & 31);
        voffA[i] = (unsigned)(R * K + C) * 2u; voffB[i] = (unsigned)(Rb * K + C) * 2u; }
    const size_t kstep = (size_t)(BK * 2);
    const size_t hstep = (size_t)HALF * K * 2;
    const size_t rstep = (size_t)K * 2;
    const unsigned ldsw = (unsigned)wid * 1024u;
    const int aoff = lds_byte(wr * 64 + fr, fq * 8), boff = lds_byte(wc * 32 + fr, fq * 8);
#define PG8_SA(b, h) (((b) * 2 + (h)) * HTB)
#define PG8_SB(b, h) ((4 + (b) * 2 + (h)) * HTB)
#define PG8_STAGE(bufoff, gbase, voff) do { _Pragma("unroll") for (int _i = 0; _i < 2; ++_i) \
        __builtin_amdgcn_global_load_lds((const unsigned*)((const char*)(gbase) + (voff)[_i]), (LAS unsigned*)(lds + (bufoff) + ldsw + _i * 8192), 16, 0, 0); } while (0)
#define PG8_LDA(dst, b, h) do { _Pragma("unroll") for (int m = 0; m < 4; ++m) _Pragma("unroll") for (int k = 0; k < 2; ++k) dst[m][k] = *(const LAS bf16x8*)(lds + PG8_SA(b, h) + aoff + m * 2048 + k * 1024); } while (0)
#define PG8_LDB(dst, b, h) do { _Pragma("unroll") for (int n = 0; n < 2; ++n) _Pragma("unroll") for (int k = 0; k < 2; ++k) dst[n][k] = *(const LAS bf16x8*)(lds + PG8_SB(b, h) + boff + n * 2048 + k * 1024); } while (0)
#define PG8_MMA(ai, bj, At, Bt) do { __builtin_amdgcn_s_setprio(1); _Pragma("unroll") for (int m = 0; m < 4; ++m) _Pragma("unroll") for (int n = 0; n < 2; ++n) _Pragma("unroll") for (int k = 0; k < 2; ++k) \
        acc[ai][bj][m][n] = __builtin_amdgcn_mfma_f32_16x16x32_bf16(Bt[n][k], At[m][k], acc[ai][bj][m][n], 0, 0, 0); __builtin_amdgcn_s_setprio(0); } while (0)
#define PG8_WAIT_V(n) asm volatile("s_waitcnt vmcnt(" #n ")" ::: "memory")
#define PG8_WAIT_L(n) asm volatile("s_waitcnt lgkmcnt(" #n ")" ::: "memory")
#define PG8_BAR __builtin_amdgcn_s_barrier()
#define PG8_SCHED __builtin_amdgcn_sched_barrier(0)
    constexpr bool GA = Sched::GATHER;
    unsigned vA[2][2];
#define PG8_GSLOT(h, i) (lds + STAGE_BYTES + ((h) * 2 + (i)) * 2048 + wid * 256)
#define PG8_GDMA(u_) do { _Pragma("unroll") for (int _i = 0; _i < 2; ++_i) { int R_, C_; stage_rc(tid * 16 + _i * 8192, R_, C_); _Pragma("unroll") for (int _h = 0; _h < 2; ++_h) \
        __builtin_amdgcn_global_load_lds((const unsigned*)(S.gidx() + ((u_).arow + _h * HALF + R_)), (LAS unsigned*)PG8_GSLOT(_h, _i), 4, 0, 0); } } while (0)
#define PG8_GOFF_G(u_) do { _Pragma("unroll") for (int _i = 0; _i < 2; ++_i) { int R_, C_; stage_rc(tid * 16 + _i * 8192, R_, C_); _Pragma("unroll") for (int _h = 0; _h < 2; ++_h) \
        vA[_h][_i] = ((unsigned)(S.gidx()[(u_).arow + _h * HALF + R_] >> 1) * (unsigned)K + (unsigned)C_) * 2u; } } while (0)
#define PG8_GOFF_L() do { _Pragma("unroll") for (int _i = 0; _i < 2; ++_i) { int R_, C_; stage_rc(tid * 16 + _i * 8192, R_, C_); _Pragma("unroll") for (int _h = 0; _h < 2; ++_h) \
        vA[_h][_i] = ((unsigned)(*(const LAS int*)(PG8_GSLOT(_h, _i) + lane * 4) >> 1) * (unsigned)K + (unsigned)C_) * 2u; } } while (0)
#define PG8_STAGE_A(bufoff, gbase, h) do { if (GA) PG8_STAGE(bufoff, gbase, vA[h]); else PG8_STAGE(bufoff, (gbase) + (h) * hstep, voffA); } while (0)
    Unit cur, nxt, nn; int ui = 0;
    if (!S.next(0, cur)) return;
    bool has_next = S.next(1, nxt);
    if (GA) { PG8_GOFF_G(cur); if (has_next) PG8_GDMA(nxt); else PG8_GDMA(cur); }
    f32x4 acc[2][2][4][2];
#pragma unroll
    for (int a = 0; a < 2; ++a)
#pragma unroll
        for (int b = 0; b < 2; ++b)
#pragma unroll
            for (int m = 0; m < 4; ++m)
#pragma unroll
                for (int n = 0; n < 2; ++n) acc[a][b][m][n] = (f32x4){0.f, 0.f, 0.f, 0.f};
    bf16x8 At[4][2], B0[2][2], B1[2][2];
    const char* cA = (const char*)g.A + (GA ? (size_t)0 : (size_t)cur.arow * rstep); const char* cB = (const char*)g.Bt + (size_t)cur.brow * rstep;
    PG8_STAGE(PG8_SB(0, 0), cB, voffB); PG8_STAGE(PG8_SB(0, 1), cB + hstep, voffB); PG8_STAGE_A(PG8_SA(0, 0), cA, 0); PG8_STAGE_A(PG8_SA(0, 1), cA, 1);
    if (wr == 1) PG8_BAR;
    PG8_WAIT_V(2); PG8_BAR;
    PG8_STAGE(PG8_SB(1, 0), cB + kstep, voffB); PG8_STAGE_A(PG8_SA(1, 0), cA + kstep, 0); PG8_STAGE(PG8_SB(1, 1), cB + hstep + kstep, voffB);
    PG8_WAIT_V(6); PG8_BAR;
    for (;;) {
        const char* nA = (has_next && !GA) ? (const char*)g.A + (size_t)nxt.arow * rstep : cA; const char* nB = has_next ? (const char*)g.Bt + (size_t)nxt.brow * rstep : cB;
        for (int t = 0; t < nt; t += 2) {
            const bool last = (t == nt - 2);
            const char* a1 = cA + (size_t)(t + 1) * kstep;
            const char* a2 = last ? nA : cA + (size_t)(t + 2) * kstep; const char* b2 = last ? nB : cB + (size_t)(t + 2) * kstep;
            const char* a3 = a2 + kstep; const char* b3 = b2 + kstep;
            PG8_LDB(B0, 0, 0); PG8_LDB(B1, 0, 1); PG8_SCHED; PG8_LDA(At, 0, 0); PG8_STAGE_A(PG8_SA(1, 1), a1, 1);
            PG8_WAIT_V(8); PG8_WAIT_L(0); PG8_BAR; PG8_MMA(0, 0, At, B0); PG8_MMA(0, 1, At, B1); PG8_BAR; PG8_SCHED;
            PG8_LDA(At, 0, 1); PG8_STAGE(PG8_SB(0, 0), b2, voffB); PG8_STAGE(PG8_SB(0, 1), b2 + hstep, voffB);
            if (GA && last) PG8_GOFF_L();
            PG8_STAGE_A(PG8_SA(0, 0), a2, 0);
            PG8_WAIT_V(8); PG8_WAIT_L(0); PG8_BAR; PG8_MMA(1, 0, At, B0); PG8_MMA(1, 1, At, B1); PG8_BAR; PG8_SCHED;
            PG8_LDB(B0, 1, 0); PG8_LDB(B1, 1, 1); PG8_SCHED; PG8_LDA(At, 1, 0); PG8_STAGE_A(PG8_SA(0, 1), a2, 1);
            PG8_WAIT_V(8); PG8_WAIT_L(0); PG8_BAR; PG8_MMA(0, 0, At, B0); PG8_MMA(0, 1, At, B1); PG8_BAR; PG8_SCHED;
            PG8_LDA(At, 1, 1); PG8_STAGE(PG8_SB(1, 0), b3, voffB); PG8_STAGE(PG8_SB(1, 1), b3 + hstep, voffB); PG8_STAGE_A(PG8_SA(1, 0), a3, 0);
            PG8_WAIT_V(8); PG8_WAIT_L(0); PG8_BAR; PG8_MMA(1, 0, At, B0); PG8_MMA(1, 1, At, B1); PG8_BAR; PG8_SCHED;
        }
        const bool has_nn = has_next && S.next(ui + 2, nn);
        if (GA) { if (has_nn) PG8_GDMA(nn); }
        if (wr == 0) PG8_BAR;
        E(acc, cur, wr, wc, fr, fq);
        if (!has_next) break;
#pragma unroll
        for (int a = 0; a < 2; ++a)
#pragma unroll
            for (int b = 0; b < 2; ++b)
#pragma unroll
                for (int m = 0; m < 4; ++m)
#pragma unroll
                    for (int n = 0; n < 2; ++n) acc[a][b][m][n] = (f32x4){0.f, 0.f, 0.f, 0.f};
        cur = nxt; nxt = nn; has_next = has_nn; cA = nA; cB = nB; ++ui;
        if (wr == 1) PG8_BAR;
    }
    PG8_WAIT_V(0);
    PG8_BAR;
#undef PG8_SA
#undef PG8_SB
#undef PG8_STAGE
#undef PG8_STAGE_A
#undef PG8_GSLOT
#undef PG8_GDMA
#undef PG8_GOFF_G
#undef PG8_GOFF_L
#undef PG8_LDA
#undef PG8_LDB
#undef PG8_MMA
#undef PG8_WAIT_V
#undef PG8_WAIT_L
#undef PG8_BAR
#undef PG8_SCHED
}

constexpr int LDS_MISC = 139264;
constexpr int LDS_BYTES = 147456;
constexpr int LDS_TAB = LDS_MISC + 64;
static_assert(LDS_TAB + CH_LAST * 16 <= LDS_BYTES, "LDS map");
constexpr int TR_PITCH = 65, TR_WAVE_BYTES = 64 * TR_PITCH * 4;
static_assert(8 * TR_WAVE_BYTES <= LDS_MISC && STAGE_BYTES <= LDS_MISC, "LDS map");

struct Params { const float* in[16]; float* out; unsigned char* ws; int lo, hi; };
enum { IN_X = 0, IN_AWIN, IN_ACONV, IN_AWOUT, IN_KVW, IN_BWQ, IN_BWO, IN_FG, IN_FU, IN_FD, IN_MR, IN_MG, IN_MU, IN_MD, IN_LNG, IN_LNB };

__device__ __forceinline__ void tr_item(const float* src, int ldw, bf16_t* dst, int K, LAS float* scr, int lane) {
    f32x4 v[16];
    const int q = lane >> 4, c4 = (lane & 15) * 4;
#pragma unroll
    for (int i = 0; i < 16; ++i) v[i] = *(const f32x4*)(src + (size_t)(4 * i + q) * ldw + c4);
#pragma unroll
    for (int i = 0; i < 16; ++i) { LAS float* s = scr + (4 * i + q) * TR_PITCH + c4; s[0] = v[i][0]; s[1] = v[i][1]; s[2] = v[i][2]; s[3] = v[i][3]; }
    asm volatile("s_waitcnt lgkmcnt(0)" ::: "memory");
    const int c = lane & 7;
#pragma unroll
    for (int j = 0; j < 8; ++j) { const int n = (lane >> 3) + 8 * j; const LAS float* s = scr + (8 * c) * TR_PITCH + n;
        u32x4 o; o.x = cvt_pk_bf16(s[0 * TR_PITCH], s[1 * TR_PITCH]); o.y = cvt_pk_bf16(s[2 * TR_PITCH], s[3 * TR_PITCH]); o.z = cvt_pk_bf16(s[4 * TR_PITCH], s[5 * TR_PITCH]); o.w = cvt_pk_bf16(s[6 * TR_PITCH], s[7 * TR_PITCH]);
        *(u32x4*)(dst + (size_t)n * K + 8 * c) = o; }
    asm volatile("s_waitcnt lgkmcnt(0)" ::: "memory");
}
__device__ __forceinline__ int tr_plain(int it, int NGW, const float* W, int ldw, int K, int ncols, bf16_t* dst, LAS float* scr, int lane) {
    const int ncb = ncols / 64, nit = (K / 64) * ncb;
    for (; it < nit; it += NGW) { const int kb = it / ncb, nb = it % ncb; tr_item(W + (size_t)(64 * kb) * ldw + 64 * nb, ldw, dst + (size_t)(64 * nb) * K + 64 * kb, K, scr, lane); }
    return it - nit;
}
__device__ __forceinline__ int tr_gu(int it, int NGW, const float* Wg, const float* Wu, int ldw, int K, int F, bf16_t* dst, LAS float* scr, int lane) {
    const int nrb = 2 * F / 64, nit = (K / 64) * nrb;
    for (; it < nit; it += NGW) { const int kb = it / nrb, rb = it % nrb, t = rb >> 2, sub = rb & 3;
        const float* W = (sub < 2 ? Wg : Wu) + 128 * t + 64 * (sub & 1);
        tr_item(W + (size_t)(64 * kb) * ldw, ldw, dst + (size_t)(64 * rb) * K + 64 * kb, K, scr, lane); }
    return it - nit;
}
__device__ __forceinline__ int tr_moe(int it, int NGW, const float* mg, const float* mu, const float* md, unsigned char* ws, LAS float* scr, int lane) {
    bf16_t* wgu = (bf16_t*)(ws + WS_WM); bf16_t* wdn = (bf16_t*)(ws + WS_WM + SZ_WMGU);
    for (int e = 0; e < NE; ++e) {
        it = tr_gu(it, NGW, mg + (size_t)e * D * DEX, mu + (size_t)e * D * DEX, DEX, D, DEX, wgu + (size_t)e * 2 * DEX * D, scr, lane);
        it = tr_plain(it, NGW, md + (size_t)e * DEX * D, D, DEX, D, wdn + (size_t)e * D * DEX, scr, lane);
    }
    return it;
}
__device__ __forceinline__ void p0_phase(const Params& p, LAS unsigned char* lds, int G, int bx) {
    const int tid = opaque_tid(), lane = tid & 63, wave = __builtin_amdgcn_readfirstlane(tid >> 6);
    LAS float* scr = (LAS float*)(lds + wave * TR_WAVE_BYTES);
    const int NGW = G * 8; int it = bx * 8 + wave;
    unsigned char* ws = p.ws;
    for (int l = 0; l < 2; ++l) {
        const float* win = p.in[IN_AWIN] + (size_t)l * D * 3 * D; bf16_t* d = (bf16_t*)(ws + WS_WIN + l * SZ_WIN);
        it = tr_gu(it, NGW, win + D, win + 2 * D, 3 * D, D, D, d, scr, lane);
        it = tr_plain(it, NGW, win, 3 * D, D, D, d + (size_t)2 * D * D, scr, lane);
        it = tr_plain(it, NGW, p.in[IN_AWOUT] + (size_t)l * D * D, D, D, D, (bf16_t*)(ws + WS_WOUT + l * SZ_WOUT), scr, lane);
        it = tr_plain(it, NGW, p.in[IN_BWO] + (size_t)l * ATTW * D, D, ATTW, D, (bf16_t*)(ws + WS_WO + l * SZ_WO), scr, lane);
        it = tr_gu(it, NGW, p.in[IN_FG] + (size_t)l * D * DFF, p.in[IN_FU] + (size_t)l * D * DFF, DFF, D, DFF, (bf16_t*)(ws + WS_WGU + l * SZ_WGU), scr, lane);
        it = tr_plain(it, NGW, p.in[IN_FD] + (size_t)l * DFF * D, D, DFF, D, (bf16_t*)(ws + WS_WDN + l * SZ_WDN), scr, lane);
    }
    it = tr_plain(it, NGW, p.in[IN_BWQ], NQ, D, NQ, (bf16_t*)(ws + WS_WQKV2), scr, lane);
    it = tr_plain(it, NGW, p.in[IN_KVW], NKV, D, NKV, (bf16_t*)(ws + WS_WQKV2) + (size_t)NQ * D, scr, lane);
    it = tr_plain(it, NGW, p.in[IN_BWQ] + (size_t)D * NQ, NQ, D, NQ, (bf16_t*)(ws + WS_WQ3), scr, lane);
    it = tr_moe(it, NGW, p.in[IN_MG], p.in[IN_MU], p.in[IN_MD], ws, scr, lane);
    const f32x4* xs = (const f32x4*)p.in[IN_X]; u32x4* xd = (u32x4*)(ws + WS_XA);
    for (size_t i = (size_t)bx * NTHR + tid; i < (size_t)M * D / 8; i += (size_t)G * NTHR) { const f32x4 a = xs[2 * i], b = xs[2 * i + 1]; xd[i] = pack8(a, b); }
}

__device__ __forceinline__ void conv_phase(const bf16_t* CU, const bf16_t* GB, bf16_t* Gb, const float* cw, int G, int bx) {
    const int tid = opaque_tid(), ch = (tid & 127) * 8, sub = tid >> 7;
    float w0[8], w1[8], w2[8];
#pragma unroll
    for (int j = 0; j < 8; ++j) { w0[j] = cw[ch + j]; w1[j] = cw[D + ch + j]; w2[j] = cw[2 * D + ch + j]; }
    for (int blk = bx; blk < M / 256; blk += G) {
        const int m0 = blk * 256 + sub * 64;
        u32x4 p2 = (u32x4){0u, 0u, 0u, 0u}, p1 = p2;
        if ((m0 & (SEQ - 1)) != 0) { p2 = *(const u32x4*)(CU + (size_t)(m0 - 2) * D + ch); p1 = *(const u32x4*)(CU + (size_t)(m0 - 1) * D + ch); }
#pragma unroll 4
        for (int i = 0; i < 64; ++i) { const size_t off = (size_t)(m0 + i) * D + ch;
            const u32x4 c0 = *(const u32x4*)(CU + off), gv = *(const u32x4*)(GB + off);
            const unsigned a2[4] = {p2.x, p2.y, p2.z, p2.w}, a1[4] = {p1.x, p1.y, p1.z, p1.w}, a0[4] = {c0.x, c0.y, c0.z, c0.w}, gg[4] = {gv.x, gv.y, gv.z, gv.w};
            unsigned o[4];
#pragma unroll
            for (int j = 0; j < 4; ++j) {
                const float lo = bf_lo(gg[j]) * (w0[2 * j] * bf_lo(a2[j]) + w1[2 * j] * bf_lo(a1[j]) + w2[2 * j] * bf_lo(a0[j]));
                const float hi = bf_hi(gg[j]) * (w0[2 * j + 1] * bf_hi(a2[j]) + w1[2 * j + 1] * bf_hi(a1[j]) + w2[2 * j + 1] * bf_hi(a0[j]));
                o[j] = cvt_pk_bf16(lo, hi); }
            *(u32x4*)(Gb + off) = (u32x4){o[0], o[1], o[2], o[3]};
            p2 = p1; p1 = c0; }
    }
}

template <int MODE>
__device__ __forceinline__ void ln_phase(const Params& p, LAS unsigned char* lds, const bf16_t* Y, const float* gam, const float* bet, const float* wrt, int G, int bx) {
    const int tid = opaque_tid(), lane = tid & 63, wave = __builtin_amdgcn_readfirstlane(tid >> 6);
    unsigned char* ws = p.ws;
    bf16_t* xa = (bf16_t*)(ws + WS_XA);
    const bf16_t* y2 = (const bf16_t*)(ws + WS_BIG + BG_Y2);
    f32x4 gv[4], bv[4];
#pragma unroll
    for (int jj = 0; jj < 4; ++jj) { gv[jj] = *(const f32x4*)(gam + 4 * lane + 256 * jj); bv[jj] = *(const f32x4*)(bet + 4 * lane + 256 * jj); }
    float wr8[MODE == 1 ? 16 : 1][8];
    if (MODE == 1) {
#pragma unroll
        for (int jj = 0; jj < 4; ++jj)
#pragma unroll
            for (int ii = 0; ii < 4; ++ii) { const f32x4 a = *(const f32x4*)(wrt + (size_t)(4 * lane + 256 * jj + ii) * NE), b = *(const f32x4*)(wrt + (size_t)(4 * lane + 256 * jj + ii) * NE + 4);
                wr8[MODE == 1 ? jj * 4 + ii : 0][0] = a[0]; wr8[MODE == 1 ? jj * 4 + ii : 0][1] = a[1]; wr8[MODE == 1 ? jj * 4 + ii : 0][2] = a[2]; wr8[MODE == 1 ? jj * 4 + ii : 0][3] = a[3];
                wr8[MODE == 1 ? jj * 4 + ii : 0][4] = b[0]; wr8[MODE == 1 ? jj * 4 + ii : 0][5] = b[1]; wr8[MODE == 1 ? jj * 4 + ii : 0][6] = b[2]; wr8[MODE == 1 ? jj * 4 + ii : 0][7] = b[3]; }
    }
    LAS int* tabE = (LAS int*)lds;
    LAS float* tabG = (LAS float*)(lds + 2048);
    LAS int* wcnt = (LAS int*)(lds + 4096);
    for (int blk = bx; blk < M / 256; blk += G) {
        u32x2 pa[4], pb[4], pc[4];
#define LN_LOAD(rw) do { const size_t o_ = (size_t)(rw) * D + 4 * lane; _Pragma("unroll") for (int jj = 0; jj < 4; ++jj) { \
            if (MODE <= 1) pa[jj] = *(const u32x2*)(Y + o_ + 256 * jj); \
            else { pa[jj] = *(const u32x2*)(xa + o_ + 256 * jj); pb[jj] = *(const u32x2*)(y2 + o_ + 256 * jj); pc[jj] = *(const u32x2*)(y2 + (size_t)M * D + o_ + 256 * jj); } } } while (0)
        LN_LOAD((size_t)blk * 256 + wave * 32);
        for (int i = 0; i < 32; ++i) {
            const int rl = wave * 32 + i; const size_t row = (size_t)blk * 256 + rl;
            f32x4 v[4];
#pragma unroll
            for (int jj = 0; jj < 4; ++jj) {
                if (MODE <= 1) { v[jj][0] = bf_lo(pa[jj].x); v[jj][1] = bf_hi(pa[jj].x); v[jj][2] = bf_lo(pa[jj].y); v[jj][3] = bf_hi(pa[jj].y); }
                else { v[jj][0] = ALPHA * bf_lo(pa[jj].x) + (bf_lo(pb[jj].x) + bf_lo(pc[jj].x)); v[jj][1] = ALPHA * bf_hi(pa[jj].x) + (bf_hi(pb[jj].x) + bf_hi(pc[jj].x));
                       v[jj][2] = ALPHA * bf_lo(pa[jj].y) + (bf_lo(pb[jj].y) + bf_lo(pc[jj].y)); v[jj][3] = ALPHA * bf_hi(pa[jj].y) + (bf_hi(pb[jj].y) + bf_hi(pc[jj].y)); } }
            if (i + 1 < 32) LN_LOAD(row + 1);
            float s = 0.f;
#pragma unroll
            for (int jj = 0; jj < 4; ++jj) s += (v[jj][0] + v[jj][1]) + (v[jj][2] + v[jj][3]);
            const float mean = wave_sum(s) * (1.0f / D); float s2 = 0.f;
#pragma unroll
            for (int jj = 0; jj < 4; ++jj) { v[jj] = v[jj] - mean; s2 += (v[jj][0] * v[jj][0] + v[jj][1] * v[jj][1]) + (v[jj][2] * v[jj][2] + v[jj][3] * v[jj][3]); }
            const float rstd = 1.0f / sqrtf(wave_sum(s2) * (1.0f / D) + LN_EPS);
#pragma unroll
            for (int jj = 0; jj < 4; ++jj) v[jj] = v[jj] * rstd * gv[jj] + bv[jj];
            if (MODE == 3) {
#pragma unroll
                for (int jj = 0; jj < 4; ++jj) *(f32x4*)(p.out + row * D + 4 * lane + 256 * jj) = v[jj];
            } else {
#pragma unroll
                for (int jj = 0; jj < 4; ++jj) { u32x2 o; o.x = cvt_pk_bf16(v[jj][0], v[jj][1]); o.y = cvt_pk_bf16(v[jj][2], v[jj][3]); *(u32x2*)(xa + row * D + 4 * lane + 256 * jj) = o; }
            }
            if (MODE == 1) {
                float lg[8];
#pragma unroll
                for (int e = 0; e < 8; ++e) { float a = 0.f;
#pragma unroll
                    for (int jj = 0; jj < 4; ++jj)
#pragma unroll
                        for (int ii = 0; ii < 4; ++ii) a += v[jj][ii] * wr8[MODE == 1 ? jj * 4 + ii : 0][e];
                    lg[e] = wave_sum(a); }
                int b1 = 0; float v1 = lg[0];
#pragma unroll
                for (int e = 1; e < 8; ++e) if (lg[e] > v1) { v1 = lg[e]; b1 = e; }
                int b2 = -1; float v2 = 0.f;
#pragma unroll
                for (int e = 0; e < 8; ++e) if (e != b1 && (b2 < 0 || lg[e] > v2)) { v2 = lg[e]; b2 = e; }
                const float ex = __expf(v2 - v1), g1 = 1.0f / (1.0f + ex), g2 = ex * g1;
                if (lane == 0) { tabE[rl * 2] = b1; tabE[rl * 2 + 1] = b2; tabG[rl * 2] = g1; tabG[rl * 2 + 1] = g2; }
            }
        }
        if (MODE == 1) {
            __syncthreads();
            const int e = tabE[tid]; int rank = 0;
#pragma unroll
            for (int x = 0; x < 8; ++x) { const unsigned long long mk = __ballot(e == x); if (e == x) rank = __popcll(mk & ((1ull << lane) - 1ull)); if (lane == 0) wcnt[wave * 8 + x] = __popcll(mk); }
            __syncthreads();
            for (int j = 0; j < wave; ++j) rank += wcnt[j * 8 + e];
            const int ent = blk * 512 + tid;
            ((int*)(ws + WS_ROUTE + RT_TOKE))[ent] = e; ((float*)(ws + WS_ROUTE + RT_TOKG))[ent] = tabG[tid]; ((int*)(ws + WS_ROUTE + RT_TOKR))[ent] = rank;
            if (tid < 8) { int c = 0; for (int j = 0; j < 8; ++j) c += wcnt[j * 8 + tid]; ((int*)(ws + CTL_CNT))[blk * 8 + tid] = c; }
            __syncthreads();
        }
    }
}

#undef LN_LOAD
__device__ __forceinline__ void scatter_phase(const Params& p, LAS unsigned char* lds, int G, int bx) {
    unsigned char* ws = p.ws; const int tid = opaque_tid(), lane = tid & 63, wave = __builtin_amdgcn_readfirstlane(tid >> 6);
    LAS int* cnt = (LAS int*)lds;
    LAS int* seg = (LAS int*)(lds + 8192);
    LAS int* base = (LAS int*)(lds + 8192 + 64);
    LAS int* eslot = (LAS int*)(lds + 8192 + 128);
    const int* gcnt = (const int*)(ws + CTL_CNT);
    const bf16_t* xa = (const bf16_t*)(ws + WS_XA); bf16_t* xg = (bf16_t*)p.out;
    int* slot_tok = (int*)(ws + WS_ROUTE + RT_SLOTT); float* slot_gate = (float*)(ws + WS_ROUTE + RT_SLOTG); int* tok_slot = (int*)(ws + WS_ROUTE + RT_TOKS);
    for (int i = tid; i < 2048; i += NTHR) cnt[i] = ld_agent(gcnt + i);
    __syncthreads();
    if (tid < 8) { int tot = 0; for (int w = 0; w < 256; ++w) tot += cnt[w * 8 + tid]; seg[8 + tid] = tot; }
    __syncthreads();
    if (tid == 0) { int s = 0; for (int e = 0; e < 8; ++e) { seg[e] = s; s += seg[8 + e]; } }
    __syncthreads();
    if (bx == 0) {
        int* tab = (int*)(ws + CTL_TAB);
        for (int t = tid; t < TILE_CAP; t += NTHR) { int e = 0, cb = 0, s0 = 0, n = 0, run = 0, segs = 0;
#pragma unroll
            for (int k = 0; k < 8; ++k) { const int nk = seg[8 + k], tk = (nk + 255) >> 8; if (t >= run && t < run + tk) { e = k; cb = run; s0 = segs; n = nk; } run += tk; segs += nk; }
            int v0 = 0, v1 = 0, v2 = 0, v3 = 0;
            if (t < run) { const int st = s0 + 256 * (t - cb), row0 = st < NSLOT - 256 ? st : NSLOT - 256, en = (st + 256 < s0 + n) ? st + 256 : s0 + n; v0 = e; v1 = row0; v2 = st - row0; v3 = en - row0; }
            tab[4 * t] = v0; tab[4 * t + 1] = v1; tab[4 * t + 2] = v2; tab[4 * t + 3] = v3;
            if (t == 0) ((int*)(ws + CTL_META))[0] = run; }
    }
    for (int blk = bx; blk < M / 256; blk += G) {
        if (tid < 8) { int b = seg[tid]; for (int w = 0; w < blk; ++w) b += cnt[w * 8 + tid]; base[tid] = b; }
        __syncthreads();
        { const int ent = blk * 512 + tid; const int e = ((const int*)(ws + WS_ROUTE + RT_TOKE))[ent], rk = ((const int*)(ws + WS_ROUTE + RT_TOKR))[ent];
          const float gt = ((const float*)(ws + WS_ROUTE + RT_TOKG))[ent]; const int slot = base[e] + rk;
          slot_tok[slot] = ent; slot_gate[slot] = gt; tok_slot[ent] = slot; eslot[tid] = slot; }
        __syncthreads();
        __syncthreads();
    }
}

constexpr int AT_P = 72;
constexpr int AT_BLK = 128 * AT_P;
__device__ __forceinline__ void attn_phase(LAS unsigned char* lds, const bf16_t* Qt, const bf16_t* Kt, const bf16_t* Vt, bf16_t* OG, float* LSE, int G, int bx) {
    const int tid = opaque_tid(), lane = tid & 63, wave = __builtin_amdgcn_readfirstlane(tid >> 6);
    LAS bf16_t* Kr = (LAS bf16_t*)lds; LAS bf16_t* Vr = Kr + 3 * AT_BLK;
    const int c = lane & 15, gq = lane >> 4, q4 = c >> 2, p4 = c & 3;
    const int q0 = 16 * wave;
    const float SC = 0.125f * 1.4426950408889634f;
    for (int i = tid; i < 2 * 3 * AT_BLK * 2 / 16; i += NTHR) ((LAS u32x4*)lds)[i] = (u32x4){0u, 0u, 0u, 0u};
    __syncthreads();
#define AT_DECODE(e, g, r, n) int g, r, n; if ((e) <= 16) { g = 0; r = 0; n = (e) == 0 ? 15 : 16 * half + (e) - 1; } else if ((e) <= 32) { g = 1; r = 2 * half + (((e) - 17) >> 3); n = ((e) - 17) & 7; } else { g = 2; r = half + 2 * (((e) - 33) >> 1); n = ((e) - 33) & 1; }
    for (int su = bx; su < 256; su += G) {
        const int b = su >> 4, h = (su >> 1) & 7, half = su & 1;
        const int e0 = half ? 0 : 1;
        u32x4 rk[2], rv[2], rq[2], rqn[2];
        rq[0] = rq[1] = (u32x4){0u, 0u, 0u, 0u};
#define AT_LOAD(e, RQ) do { AT_DECODE(e, g_, r_, n_); const int L_ = 4096 >> (2 * g_); const size_t seg_ = ((size_t)((b * 3 + g_) * 8 + h) * 4096 + (size_t)r_ * L_ + (size_t)n_ * 128) * 64; \
        _Pragma("unroll") for (int i_ = 0; i_ < 2; ++i_) { rk[i_] = *(const u32x4*)(Kt + seg_ + (size_t)(tid + 512 * i_) * 8); rv[i_] = *(const u32x4*)(Vt + seg_ + (size_t)(tid + 512 * i_) * 8); } \
        _Pragma("unroll") for (int ks_ = 0; ks_ < 2; ++ks_) RQ[ks_] = *(const u32x4*)(Qt + seg_ + (size_t)(q0 + c) * 64 + 32 * ks_ + 8 * gq); } while (0)
#define AT_WRITE(slot) do { _Pragma("unroll") for (int i_ = 0; i_ < 2; ++i_) { const int id_ = tid + 512 * i_; \
        *(LAS u32x4*)(Kr + (slot) * AT_BLK + (id_ >> 3) * AT_P + (id_ & 7) * 8) = rk[i_]; *(LAS u32x4*)(Vr + (slot) * AT_BLK + (id_ >> 3) * AT_P + (id_ & 7) * 8) = rv[i_]; } } while (0)
        AT_LOAD(e0, rq);
        __syncthreads();
        AT_WRITE(e0 % 3);
        asm volatile("" : "+v"(rq[0]), "+v"(rq[1]));
        __syncthreads();
        for (int e = e0; e < 49; ++e) {
            if (e + 1 < 49) AT_LOAD(e + 1, rqn);
            if (e > 0) {
                AT_DECODE(e, g, r, n);
                const int cur = e % 3, prv = (e + 2) % 3;
                const int tskip = (n == 0) ? 8 - wave : 0;
                bf16x8 qf[2]; __builtin_memcpy(&qf[0], &rq[0], 16); __builtin_memcpy(&qf[1], &rq[1], 16);
                f32x4 s[9];
#pragma unroll
                for (int t = 0; t < 9; ++t) { s[t] = (f32x4){0.f, 0.f, 0.f, 0.f};
                    if (t >= tskip) { const int kb = q0 + 16 * t; const LAS bf16_t* kp = Kr + ((kb >> 7) ? cur : prv) * AT_BLK + ((kb & 127) + c) * AT_P + 8 * gq;
#pragma unroll
                        for (int ks = 0; ks < 2; ++ks) { const bf16x8 kf = *(const LAS bf16x8*)(kp + 32 * ks); s[t] = __builtin_amdgcn_mfma_f32_16x16x32_bf16(kf, qf[ks], s[t], 0, 0, 0); } } }
#pragma unroll
                for (int jx = 0; jx < 4; ++jx) { if (4 * gq + jx < c) s[0][jx] = -INFINITY; if (4 * gq + jx > c) s[8][jx] = -INFINITY; }
                float mx = -INFINITY;
#pragma unroll
                for (int t = 0; t < 9; ++t) { if (t < tskip) s[t] = (f32x4){-INFINITY, -INFINITY, -INFINITY, -INFINITY};
#pragma unroll
                    for (int jx = 0; jx < 4; ++jx) mx = fmaxf(mx, s[t][jx]); }
                mx = fmaxf(mx, shx(mx, 16, lane)); mx = fmaxf(mx, shx(mx, 32, lane));
                const float mxs = mx * SC; float ls = 0.f;
#pragma unroll
                for (int t = 0; t < 9; ++t)
#pragma unroll
                    for (int jx = 0; jx < 4; ++jx) { const float pv = __builtin_amdgcn_exp2f(s[t][jx] * SC - mxs); s[t][jx] = pv; ls += pv; }
                ls += shx(ls, 16, lane); ls += shx(ls, 32, lane);
                f32x4 o[4];
#pragma unroll
                for (int dt = 0; dt < 4; ++dt) o[dt] = (f32x4){0.f, 0.f, 0.f, 0.f};
#pragma unroll
                for (int s5 = 0; s5 < 4; ++s5) {
                    if (2 * s5 + 1 >= tskip) {
                        const u32x4 pw = pack8(s[2 * s5], s[2 * s5 + 1]); bf16x8 pf; __builtin_memcpy(&pf, &pw, 16);
                        const int kb0 = q0 + 32 * s5, kb1 = kb0 + 16;
                        const LAS bf16_t* vp0 = Vr + ((kb0 >> 7) ? cur : prv) * AT_BLK + ((kb0 & 127) + 4 * gq + q4) * AT_P + 4 * p4;
                        const LAS bf16_t* vp1 = Vr + ((kb1 >> 7) ? cur : prv) * AT_BLK + ((kb1 & 127) + 4 * gq + q4) * AT_P + 4 * p4;
#pragma unroll
                        for (int dt = 0; dt < 4; ++dt) {
                            const bf16x4 v0 = __builtin_amdgcn_ds_read_tr16_b64_v4i16((LAS bf16x4*)(vp0 + 16 * dt));
                            const bf16x4 v1 = __builtin_amdgcn_ds_read_tr16_b64_v4i16((LAS bf16x4*)(vp1 + 16 * dt));
                            const bf16x8 vf = (bf16x8){v0[0], v0[1], v0[2], v0[3], v1[0], v1[1], v1[2], v1[3]};
                            o[dt] = __builtin_amdgcn_mfma_f32_16x16x32_bf16(vf, pf, o[dt], 0, 0, 0); } } }
                {
                    u32x2 pw; pw.x = cvt_pk_bf16(s[8][0], s[8][1]); pw.y = cvt_pk_bf16(s[8][2], s[8][3]); bf16x4 pf4; __builtin_memcpy(&pf4, &pw, 8);
                    const LAS bf16_t* vp = Vr + cur * AT_BLK + (q0 + 4 * gq + q4) * AT_P + 4 * p4;
#pragma unroll
                    for (int dt = 0; dt < 4; ++dt) { const bf16x4 v0 = __builtin_amdgcn_ds_read_tr16_b64_v4i16((LAS bf16x4*)(vp + 16 * dt)); o[dt] = __builtin_amdgcn_mfma_f32_16x16x16bf16_1k(v0, pf4, o[dt], 0, 0, 0); } }
                const float inv = 1.0f / ls;
                const int token = b * 4096 + (((n * 128 + q0 + c) << (2 * g)) + r);
                bf16_t* od = OG + ((size_t)token * 3 + g) * ATTW + h * 64 + 4 * gq;
#pragma unroll
                for (int dt = 0; dt < 4; ++dt) { u32x2 w; w.x = cvt_pk_bf16(o[dt][0] * inv, o[dt][1] * inv); w.y = cvt_pk_bf16(o[dt][2] * inv, o[dt][3] * inv); *(u32x2*)(od + 16 * dt) = w; }
                if (gq == 0) LSE[((size_t)token * 3 + g) * 8 + h] = (mxs + __builtin_amdgcn_logf(ls)) * 0.6931471805599453f;
            }
            if (e + 1 < 49) AT_WRITE((e + 1) % 3);
            __syncthreads();
            rq[0] = rqn[0]; rq[1] = rqn[1];
        }
#undef AT_LOAD
#undef AT_WRITE
    }
#undef AT_DECODE
}
__device__ __forceinline__ void combine_phase(const bf16_t* OG, const float* LSE, bf16_t* O, int G, int bx) {
    const int tid = opaque_tid();
    for (size_t it = (size_t)bx * NTHR + tid; it < (size_t)M * 64; it += (size_t)G * NTHR) {
        const size_t token = it >> 6; const int h = (int)(it >> 3) & 7, ch = (int)it & 7;
        const float l0 = LSE[(token * 3 + 0) * 8 + h], l1 = LSE[(token * 3 + 1) * 8 + h], l2 = LSE[(token * 3 + 2) * 8 + h];
        const float mx = fmaxf(l0, fmaxf(l1, l2)); float w0 = __expf(l0 - mx), w1 = __expf(l1 - mx), w2 = __expf(l2 - mx); const float inv = 1.0f / (w0 + w1 + w2); w0 *= inv; w1 *= inv; w2 *= inv;
        const u32x4 a = *(const u32x4*)(OG + (token * 3 + 0) * ATTW + h * 64 + ch * 8), b = *(const u32x4*)(OG + (token * 3 + 1) * ATTW + h * 64 + ch * 8), c = *(const u32x4*)(OG + (token * 3 + 2) * ATTW + h * 64 + ch * 8);
        const unsigned aa[4] = {a.x, a.y, a.z, a.w}, bb[4] = {b.x, b.y, b.z, b.w}, cc[4] = {c.x, c.y, c.z, c.w}; unsigned o[4];
#pragma unroll
        for (int j = 0; j < 4; ++j) o[j] = cvt_pk_bf16(w0 * bf_lo(aa[j]) + w1 * bf_lo(bb[j]) + w2 * bf_lo(cc[j]), w0 * bf_hi(aa[j]) + w1 * bf_hi(bb[j]) + w2 * bf_hi(cc[j]));
        *(u32x4*)(O + token * ATTW + h * 64 + ch * 8) = (u32x4){o[0], o[1], o[2], o[3]};
    }
}

__global__ void __launch_bounds__(NTHR, 2) mk_fwd(Params p) {
    extern __shared__ __attribute__((aligned(16))) unsigned char lds_raw[];
    LAS unsigned char* lds = (LAS unsigned char*)lds_raw;
    constexpr int G = NWG; const int bx = blockIdx.x;
    unsigned char* ws = p.ws;
    volatile LAS unsigned* MISC = (volatile LAS unsigned*)(lds + LDS_MISC);
    if (threadIdx.x < 4) MISC[threadIdx.x] = 0u;
    __syncthreads();
    XcdBarrier bar = xcd_barrier_post((unsigned*)(ws + WS_CTL) + CW_BAR, MISC);
    int pc = 0;
#define PH_IF if (pc >= p.lo && pc < p.hi)
#define PH_END do { if (pc >= p.lo && pc + 1 < p.hi) xcd_barrier(bar); ++pc; } while (0)
    bf16_t* xa = (bf16_t*)(ws + WS_XA);
    unsigned char* big = ws + WS_BIG;
    const float* ln_g = p.in[IN_LNG]; const float* ln_b = p.in[IN_LNB];

    PH_IF { p0_phase(p, lds, G, opq_i(bx)); } PH_END;

    for (int pr = 0; pr < 2; ++pr) {
        for (int q = 0; q < 2; ++q) {
            const int l = 2 * pr + q;
            bf16_t* ysrc;
            if (pr == 0) {
                PH_IF { Gemm g{xa, (const bf16_t*)(ws + WS_WIN + l * SZ_WIN), D}; DenseOrder S; S.init(M, 3 * D, G, opq_i(bx), 0);
                        EpiCU E{(bf16_t*)(big + BG_CU), (bf16_t*)(big + BG_GB)}; gemm_phase(lds, g, S, E); } PH_END;
                PH_IF { conv_phase((const bf16_t*)(big + BG_CU), (const bf16_t*)(big + BG_GB), (bf16_t*)(big + BG_G), p.in[IN_ACONV] + (size_t)l * 3 * D, G, opq_i(bx)); } PH_END;
                ysrc = (bf16_t*)p.out;
            } else {
                PH_IF { Gemm g{xa, (const bf16_t*)(ws + (q == 0 ? WS_WQKV2 : WS_WQ3)), D}; DenseOrder S; S.init(M, q == 0 ? NQ + NKV : NQ, G, opq_i(bx), 0);
                        EpiQKV E{(bf16_t*)((unsigned char*)p.out + DO_Q), (bf16_t*)(big + BG_K)}; gemm_phase(lds, g, S, E); } PH_END;
                PH_IF { attn_phase(lds, (const bf16_t*)((unsigned char*)p.out + DO_Q), (const bf16_t*)(big + BG_K), (const bf16_t*)(big + BG_V), (bf16_t*)(big + BG_OG), (float*)(big + BG_LSE), G, opq_i(bx)); } PH_END;
                PH_IF { combine_phase((const bf16_t*)(big + BG_OG), (const float*)(big + BG_LSE), (bf16_t*)((unsigned char*)p.out + DO_O), G, opq_i(bx)); } PH_END;
                ysrc = (bf16_t*)(big + BG_YATT);
            }
            PH_IF { Gemm g; if (pr == 0) g = Gemm{(const bf16_t*)(big + BG_G), (const bf16_t*)(ws + WS_WOUT + l * SZ_WOUT), D}; else g = Gemm{(const bf16_t*)((unsigned char*)p.out + DO_O), (const bf16_t*)(ws + WS_WO + q * SZ_WO), ATTW};
                    DenseOrder S; S.init(M, D, G, opq_i(bx), 0); EpiResid E{ysrc, xa}; gemm_phase(lds, g, S, E); } PH_END;
            if (q == 0) { PH_IF { ln_phase<0>(p, lds, ysrc, ln_g + (size_t)(l * 2) * D, ln_b + (size_t)(l * 2) * D, nullptr, G, opq_i(bx)); } PH_END; }
            else        { PH_IF { ln_phase<1>(p, lds, ysrc, ln_g + (size_t)(l * 2) * D, ln_b + (size_t)(l * 2) * D, p.in[IN_MR] + (size_t)pr * D * NE, G, opq_i(bx)); } PH_END; }
            if (q == 0) {
                for (int hf = 0; hf < 2; ++hf) {
                    PH_IF { Gemm g{xa + (size_t)hf * (M / 2) * D, (const bf16_t*)(ws + WS_WGU + pr * SZ_WGU), D}; DenseOrder S; S.init(M / 2, 2 * DFF, G, opq_i(bx), 0);
                            EpiSwiGLU E{(bf16_t*)(big + BG_HH), DFF}; gemm_phase(lds, g, S, E); } PH_END;
                    PH_IF { Gemm g{(const bf16_t*)(big + BG_HH), (const bf16_t*)(ws + WS_WDN + pr * SZ_WDN), DFF}; DenseOrder S; S.init(M / 2, D, G, opq_i(bx), hf * (M / 2));
                            EpiResid E{(bf16_t*)p.out, xa}; gemm_phase(lds, g, S, E); } PH_END;
                }
                PH_IF { ln_phase<0>(p, lds, (const bf16_t*)p.out, ln_g + (size_t)(l * 2 + 1) * D, ln_b + (size_t)(l * 2 + 1) * D, nullptr, G, opq_i(bx)); } PH_END;
            } else {
                PH_IF { scatter_phase(p, lds, G, opq_i(bx)); } PH_END;
                for (int cch = 0; cch < NCHUNK; ++cch) {
                    PH_IF { const int T = __builtin_amdgcn_readfirstlane(ld_agent((const int*)(ws + CTL_META))); int px = T - NCHUNK * CH_TILES; px = px < 0 ? 0 : (px > CH_LAST - CH_TILES ? CH_LAST - CH_TILES : px);
                            const int t0 = cch <= 1 ? cch * CH_TILES : cch * CH_TILES + px; int ntab = T - t0; { const int cap = cch <= 1 ? CH_TILES + px : CH_TILES; ntab = ntab < 0 ? 0 : (ntab > cap ? cap : ntab); }
                            LAS int* ltab = (LAS int*)(lds + LDS_TAB);
                            const int r0 = moe_tab_to_lds((const int*)(ws + CTL_TAB), t0, ntab, ltab);
                            int skip = 0, xt = 1 << 30, row0x = 0, H = 0, row0c = r0;
                            if (cch == 0 && px > 0 && ntab == CH_TILES + px) { xt = CH_TILES; row0x = __builtin_amdgcn_readfirstlane(ltab[4 * CH_TILES + 1]) - XROW; }
                            if (cch == 1 && px > 0 && ntab == CH_TILES + px) {
                                Gemm gx{(const bf16_t*)(big + BG_HC), (const bf16_t*)(ws + WS_WM + SZ_WMGU), DEX}; MoeOrder<false> SX{nullptr, (const LAS int*)ltab, px, D / BM, G, opq_i(bx), r0 - XROW, D, 1, 1 << 30, 0, 0};
                                EpiMoeDown EX{(bf16_t*)(big + BG_Y2), (const int*)(ws + WS_ROUTE + RT_SLOTT), (const float*)(ws + WS_ROUTE + RT_SLOTG)}; gemm_phase(lds, gx, SX, EX);
                                skip = px; row0c = __builtin_amdgcn_readfirstlane(ltab[4 * px + 1]); H = 4 * px; }
                            Gemm g{xa, (const bf16_t*)(ws + WS_WM), D}; MoeOrder<true> S{(const int*)(ws + WS_ROUTE + RT_SLOTT), (const LAS int*)(ltab + 4 * skip), ntab - skip, 2 * DEX / BM, G, opq_i(bx), row0c, 2 * DEX, 0, xt, row0x, H};
                            EpiSwiGLU E{(bf16_t*)(big + BG_HC), DEX}; gemm_phase(lds, g, S, E); } PH_END;
                    PH_IF { const int T = __builtin_amdgcn_readfirstlane(ld_agent((const int*)(ws + CTL_META))); int px = T - NCHUNK * CH_TILES; px = px < 0 ? 0 : (px > CH_LAST - CH_TILES ? CH_LAST - CH_TILES : px);
                            const int t0 = cch == 0 ? 0 : cch * CH_TILES + px; int nt = T - t0; nt = nt < 0 ? 0 : (nt > CH_TILES ? CH_TILES : nt);
                            const int row0c = moe_tab_to_lds((const int*)(ws + CTL_TAB), t0, nt, (LAS int*)(lds + LDS_TAB));
                            Gemm g{(const bf16_t*)(big + BG_HC), (const bf16_t*)(ws + WS_WM + SZ_WMGU), DEX}; MoeOrder<false> S{nullptr, (const LAS int*)(lds + LDS_TAB), nt, D / BM, G, opq_i(bx), row0c, D, 1, 1 << 30, 0, 0};
                            EpiMoeDown E{(bf16_t*)(big + BG_Y2), (const int*)(ws + WS_ROUTE + RT_SLOTT), (const float*)(ws + WS_ROUTE + RT_SLOTG)}; gemm_phase(lds, g, S, E); } PH_END;
                }
                if (l == 1) { PH_IF { ln_phase<2>(p, lds, nullptr, ln_g + (size_t)(l * 2 + 1) * D, ln_b + (size_t)(l * 2 + 1) * D, nullptr, G, opq_i(bx));
                                      __syncthreads();
                                      const int t2 = opaque_tid(), wave2 = __builtin_amdgcn_readfirstlane(t2 >> 6); LAS float* scr = (LAS float*)(lds + wave2 * TR_WAVE_BYTES);
                                      tr_moe(opq_i(bx) * 8 + wave2, G * 8, p.in[IN_MG] + (size_t)NE * D * DEX, p.in[IN_MU] + (size_t)NE * D * DEX, p.in[IN_MD] + (size_t)NE * DEX * D, ws, scr, t2 & 63); } PH_END; }
                else        { PH_IF { ln_phase<3>(p, lds, nullptr, ln_g + (size_t)(l * 2 + 1) * D, ln_b + (size_t)(l * 2 + 1) * D, nullptr, G, opq_i(bx)); } PH_END; }
            }
        }
    }
#undef PH_IF
#undef PH_END
}
constexpr int NPHASE = 49;

#if MK_DEBUG
enum { K_P0 = 0, K_GIN, K_CONV, K_RESA, K_LN0, K_LN1, K_GU, K_DN, K_LNF, K_SCAT, K_MGU, K_MDN, K_LNM, K_QKV, K_ATT, K_COMB, K_RESB };
__device__ __forceinline__ float bf2f(bf16_t v) { return __uint_as_float((unsigned)v << 16); }
__device__ float dot_a(const bf16_t* a, const float* W, int ldw, int K, float& nrm) { float s = 0.f, q = 0.f; for (int k = 0; k < K; ++k) { const float t = bf2f(a[k]) * W[(size_t)k * ldw]; s += t; q += t * t; } nrm = sqrtf(q); return s; }
__device__ bool closef(float got, float ref, float nrm) { return fabsf(got - ref) <= 0.02f * fabsf(ref) + 0.02f * nrm + 2e-3f && got == got; }
__device__ unsigned hsh(unsigned x) { x ^= x >> 16; x *= 0x7feb352du; x ^= x >> 15; x *= 0x846ca68bu; x ^= x >> 16; return x; }
__device__ int pick_row(unsigned sid, int nrows) { switch (sid) { case 0: return 0; case 1: return 1; case 2: return 255; case 3: return 256; case 4: return 257; case 5: return nrows - 1; case 6: return nrows - 256; case 7: return nrows / 2 + 127; default: break; } return (int)(hsh(sid * 2u + 1u) % (unsigned)nrows); }
__global__ void mk_check(Params p, int kind, int l, int a0, int pc) {
    const unsigned sid = blockIdx.x * blockDim.x + threadIdx.x; unsigned char* ws = p.ws; unsigned char* big = ws + WS_BIG;
    unsigned* dbg = (unsigned*)(ws + WS_CTL) + CW_DBG; const bf16_t* xa = (const bf16_t*)(ws + WS_XA);
    bool ok = true; float n1, n2;
    if (kind == K_GIN) { const int m = pick_row(sid, M), c = hsh(sid) % D; const float* W = p.in[IN_AWIN] + (size_t)l * D * 3 * D;
        const float rb = dot_a(xa + (size_t)m * D, W + c, 3 * D, D, n1); ok = closef(bf2f(((const bf16_t*)(big + BG_GB))[(size_t)m * D + c]), rb, n1);
        const float rc = dot_a(xa + (size_t)m * D, W + D + c, 3 * D, D, n1), ru = dot_a(xa + (size_t)m * D, W + 2 * D + c, 3 * D, D, n2);
        ok = ok && closef(bf2f(((const bf16_t*)(big + BG_CU))[(size_t)m * D + c]), rc * ru, fabsf(rc) * n2 + fabsf(ru) * n1);
    } else if (kind == K_CONV) { const int m = pick_row(sid, M), c = hsh(sid) % D, s = m & (SEQ - 1); const bf16_t* CU = (const bf16_t*)(big + BG_CU); const float* cw = p.in[IN_ACONV] + (size_t)l * 3 * D;
        float cv = cw[2 * D + c] * bf2f(CU[(size_t)m * D + c]); if (s >= 1) cv += cw[D + c] * bf2f(CU[(size_t)(m - 1) * D + c]); if (s >= 2) cv += cw[c] * bf2f(CU[(size_t)(m - 2) * D + c]);
        const float ref = bf2f(((const bf16_t*)(big + BG_GB))[(size_t)m * D + c]) * cv; ok = closef(bf2f(((const bf16_t*)(big + BG_G))[(size_t)m * D + c]), ref, 0.f);
    } else if (kind == K_RESA) { const int m = pick_row(sid, M), c = hsh(sid) % D; const float ref = ALPHA * bf2f(xa[(size_t)m * D + c]) + dot_a((const bf16_t*)(big + BG_G) + (size_t)m * D, p.in[IN_AWOUT] + (size_t)l * D * D + c, D, D, n1);
        ok = closef(bf2f(((const bf16_t*)p.out)[(size_t)m * D + c]), ref, n1);
    } else if (kind == K_RESB) { const int m = pick_row(sid, M), c = hsh(sid) % D; const float ref = ALPHA * bf2f(xa[(size_t)m * D + c]) + dot_a((const bf16_t*)((unsigned char*)p.out + DO_O) + (size_t)m * ATTW, p.in[IN_BWO] + (size_t)(l - 2) * ATTW * D + c, D, ATTW, n1);
        ok = closef(bf2f(((const bf16_t*)(big + BG_YATT))[(size_t)m * D + c]), ref, n1);
    } else if (kind == K_LN0 || kind == K_LN1 || kind == K_LNF) { const int m = pick_row(sid, M), c = hsh(sid) % D; const bf16_t* Yb = (kind == K_LNF || l < 2) ? (const bf16_t*)p.out : (const bf16_t*)(big + BG_YATT); const int which = (kind == K_LNF) ? 1 : 0;
        const float* gm = p.in[IN_LNG] + (size_t)(l * 2 + which) * D; const float* bt = p.in[IN_LNB] + (size_t)(l * 2 + which) * D;
        float mu = 0.f; for (int k = 0; k < D; ++k) mu += bf2f(Yb[(size_t)m * D + k]); mu /= D; float var = 0.f; for (int k = 0; k < D; ++k) { const float d = bf2f(Yb[(size_t)m * D + k]) - mu; var += d * d; } var /= D; const float rs = 1.0f / sqrtf(var + LN_EPS);
        ok = closef(bf2f(xa[(size_t)m * D + c]), (bf2f(Yb[(size_t)m * D + c]) - mu) * rs * gm[c] + bt[c], 0.f);
        if (kind == K_LN1) { const float* wr = p.in[IN_MR] + (size_t)(l / 2) * D * NE; int b1 = -1, b2 = -1; float v1 = -1e30f, v2 = -1e30f, v3 = -1e30f;
            for (int e = 0; e < 8; ++e) { float a = 0.f; for (int k = 0; k < D; ++k) a += ((bf2f(Yb[(size_t)m * D + k]) - mu) * rs * gm[k] + bt[k]) * wr[k * NE + e];
                if (a > v1) { v3 = v2; v2 = v1; b2 = b1; v1 = a; b1 = e; } else if (a > v2) { v3 = v2; v2 = a; b2 = e; } else if (a > v3) v3 = a; }
            const int e1 = ((const int*)(ws + WS_ROUTE + RT_TOKE))[m * 2], e2 = ((const int*)(ws + WS_ROUTE + RT_TOKE))[m * 2 + 1]; const float g1 = ((const float*)(ws + WS_ROUTE + RT_TOKG))[m * 2], g2 = ((const float*)(ws + WS_ROUTE + RT_TOKG))[m * 2 + 1];
            const bool tie = (v1 - v2 < 1e-3f) || (v2 - v3 < 1e-3f); const float r1 = 1.0f / (1.0f + expf(v2 - v1));
            if (!tie) ok = ok && e1 == b1 && e2 == b2 && fabsf(g1 - r1) < 2e-3f && fabsf(g1 + g2 - 1.0f) < 1e-4f; }
    } else if (kind == K_GU) { const int mr = pick_row(sid, M / 2), f = hsh(sid) % DFF, m = a0 * (M / 2) + mr; const int i = l / 2;
        const float rg = dot_a(xa + (size_t)m * D, p.in[IN_FG] + (size_t)i * D * DFF + f, DFF, D, n1), ru = dot_a(xa + (size_t)m * D, p.in[IN_FU] + (size_t)i * D * DFF + f, DFF, D, n2);
        const float sg = rg / (1.0f + expf(-rg)); ok = closef(bf2f(((const bf16_t*)(big + BG_HH))[(size_t)mr * DFF + f]), sg * ru, fabsf(sg) * n2 + fabsf(ru) * n1);
    } else if (kind == K_DN) { const int mr = pick_row(sid, M / 2), c = hsh(sid) % D, m = a0 * (M / 2) + mr; const int i = l / 2;
        const float ref = ALPHA * bf2f(xa[(size_t)m * D + c]) + dot_a((const bf16_t*)(big + BG_HH) + (size_t)mr * DFF, p.in[IN_FD] + (size_t)i * DFF * D + c, D, DFF, n1); ok = closef(bf2f(((const bf16_t*)p.out)[(size_t)m * D + c]), ref, n1);
    } else if (kind == K_SCAT) { const int* tok_slot = (const int*)(ws + WS_ROUTE + RT_TOKS); const int* slot_tok = (const int*)(ws + WS_ROUTE + RT_SLOTT); const int* tok_e = (const int*)(ws + WS_ROUTE + RT_TOKE); const int* gcnt = (const int*)(ws + CTL_CNT);
        for (int ent = sid; ent < NSLOT; ent += gridDim.x * blockDim.x) { const int slot = tok_slot[ent]; if (slot < 0 || slot >= NSLOT || slot_tok[slot] != ent) ok = false; }
        const int ent = hsh(sid) % NSLOT, slot = tok_slot[ent], e = tok_e[ent]; int s0 = 0, n = 0; for (int x = 0; x < 8; ++x) { int t = 0; for (int w = 0; w < 256; ++w) t += gcnt[w * 8 + x]; if (x < e) s0 += t; if (x == e) n = t; }
        if (slot >= 0 && slot < NSLOT) { if (slot < s0 || slot >= s0 + n) ok = false; const int c = hsh(sid + 77u) % D; if (((const bf16_t*)p.out)[(size_t)slot * D + c] != xa[(size_t)(ent >> 1) * D + c]) ok = false; }
        if (sid == 0) { const int T = ((const int*)(ws + CTL_META))[0]; if (T < 512 || T > 520) ok = false; }
    } else if (kind == K_MGU || kind == K_MDN) { const int* tab = (const int*)(ws + CTL_TAB); const int T = ((const int*)(ws + CTL_META))[0]; const int t0 = a0 * CH_TILES; int nt = T - t0; const int cap = (a0 == NCHUNK - 1) ? CH_LAST : CH_TILES; nt = nt < 0 ? 0 : (nt > cap ? cap : nt);
        if (nt > 0) { const int t = t0 + hsh(sid) % nt, e = tab[4 * t], row0 = tab[4 * t + 1], lo = tab[4 * t + 2], hi = tab[4 * t + 3], row0c = tab[4 * t0 + 1];
            const int r = (sid & 3) == 0 ? lo : ((sid & 3) == 1 ? hi - 1 : lo + hsh(sid + 5u) % (hi - lo)); const int slot = row0 + r; const int i = l / 2;
            const int ent = ((const int*)(ws + WS_ROUTE + RT_SLOTT))[slot]; if (((const int*)(ws + WS_ROUTE + RT_TOKE))[ent] != e) ok = false;
            const bf16_t* hrow = (const bf16_t*)(big + BG_HC) + (size_t)(slot - row0c) * DEX;
            if (kind == K_MGU) { const int f = hsh(sid + 9u) % DEX; const bf16_t* xr = (const bf16_t*)p.out + (size_t)slot * D; const size_t wo = ((size_t)i * NE + e) * D * DEX + f;
                const float rg = dot_a(xr, p.in[IN_MG] + wo, DEX, D, n1), ru = dot_a(xr, p.in[IN_MU] + wo, DEX, D, n2); const float sg = rg / (1.0f + expf(-rg));
                ok = ok && closef(bf2f(hrow[f]), sg * ru, fabsf(sg) * n2 + fabsf(ru) * n1);
            } else { const int c = hsh(sid + 9u) % D; const float gt = ((const float*)(ws + WS_ROUTE + RT_SLOTG))[slot];
                const float ref = gt * dot_a(hrow, p.in[IN_MD] + ((size_t)i * NE + e) * DEX * D + c, D, DEX, n1);
                ok = ok && closef(bf2f(((const bf16_t*)(big + BG_Y2))[((size_t)(ent & 1) * M + (ent >> 1)) * D + c]), ref, gt * n1); } }
    } else if (kind == K_QKV) { const int m = pick_row(sid, M), ncol = (l == 2) ? NQ + NKV : NQ, c = hsh(sid) % ncol; float ref; bf16_t got;
        if (c < NQ) { ref = dot_a(xa + (size_t)m * D, p.in[IN_BWQ] + (size_t)(l - 2) * D * NQ + c, NQ, D, n1); got = ((const bf16_t*)((unsigned char*)p.out + DO_Q))[resid_off(m, c >> 9, (c >> 6) & 7, c & 63)]; }
        else { const int c2 = c - NQ; ref = dot_a(xa + (size_t)m * D, p.in[IN_KVW] + c2, NKV, D, n1); got = ((const bf16_t*)(big + (((c2 >> 9) & 1) ? BG_V : BG_K)))[resid_off(m, c2 >> 10, (c2 >> 6) & 7, c2 & 63)]; }
        ok = closef(bf2f(got), ref, n1);
    } else if (kind == K_ATT) { const int m = pick_row(sid, M), g = hsh(sid) % 3, h = hsh(sid + 3u) % 8, d = 1 << (2 * g), b = m >> 12, s = m & 4095; const bf16_t* Q = (const bf16_t*)((unsigned char*)p.out + DO_Q); const bf16_t* K = (const bf16_t*)(big + BG_K); const bf16_t* V = (const bf16_t*)(big + BG_V);
        float mx = -1e30f; const int ev = hsh(sid + 11u) % 64; float den = 0.f, o = 0.f;
        for (int pass = 0; pass < 2; ++pass) for (int j = 0; j <= 128; ++j) { const int sk = s - j * d; if (sk < 0) break; float a = 0.f; for (int e = 0; e < 64; ++e) a += bf2f(Q[resid_off(m, g, h, e)]) * bf2f(K[resid_off(b * 4096 + sk, g, h, e)]); a *= 0.125f;
            if (pass == 0) mx = fmaxf(mx, a); else { const float pe = expf(a - mx); den += pe; o += pe * bf2f(V[resid_off(b * 4096 + sk, g, h, ev)]); } }
        o /= den; const int e = ev;
        ok = closef(bf2f(((const bf16_t*)(big + BG_OG))[((size_t)m * 3 + g) * ATTW + h * 64 + e]), o, 0.02f) && closef(((const float*)(big + BG_LSE))[((size_t)m * 3 + g) * 8 + h], mx + logf(den), 0.05f);
    } else if (kind == K_COMB) { const int m = pick_row(sid, M), h = hsh(sid) % 8, e = hsh(sid + 3u) % 64; const float* L = (const float*)(big + BG_LSE) + (size_t)m * 24 + h; const float mx = fmaxf(L[0], fmaxf(L[8], L[16]));
        const float w0 = expf(L[0] - mx), w1 = expf(L[8] - mx), w2 = expf(L[16] - mx); const bf16_t* og = (const bf16_t*)(big + BG_OG) + (size_t)m * 3 * ATTW + h * 64 + e;
        ok = closef(bf2f(((const bf16_t*)((unsigned char*)p.out + DO_O))[(size_t)m * ATTW + h * 64 + e]), (w0 * bf2f(og[0]) + w1 * bf2f(og[ATTW]) + w2 * bf2f(og[2 * ATTW])) / (w0 + w1 + w2), 0.02f);
    }
    if (!ok) atomicAdd(&dbg[1 + pc], 1u);
    if (sid == 0 && ((const unsigned*)(ws + WS_CTL))[CW_BAR + XB_TMO] != 0u) atomicAdd(&dbg[1 + 98], 1u);
}
__global__ void mk_report(float* out, const unsigned* dbg) {
    int code = 0; for (int pc = 0; pc < 99 && code == 0; ++pc) if (dbg[1 + pc] > (pc == 98 ? 0u : 12u)) code = pc + 1;
    if (code == 0) return;
    const float V = sqrtf(100.0f * (float)code);
    for (size_t i = (size_t)blockIdx.x * blockDim.x + threadIdx.x; i < (size_t)M * D; i += (size_t)gridDim.x * blockDim.x) out[i] = V;
}
#endif
}

extern "C" void kernel_launch(void* const* d_in, const int* in_sizes, int n_in, void* d_out, int out_size, void* d_ws, size_t ws_size, hipStream_t stream) {
    using namespace mk;
    static int grid = 0;
    if (grid == 0) {
        if (n_in != 16 || in_sizes[0] != M * D || out_size != M * D || ws_size < WS_NEED) { fprintf(stderr, "kernel_launch: unexpected shapes (n_in %d, in0 %d, out %d, ws %zu, need %zu)\n", n_in, n_in > 0 ? in_sizes[0] : -1, out_size, ws_size, (size_t)WS_NEED); grid = -1; return; }
        int dev = 0, cus = 0, per_cu = 0;
        if (hipGetDevice(&dev) != hipSuccess || hipDeviceGetAttribute(&cus, hipDeviceAttributeMultiprocessorCount, dev) != hipSuccess) { grid = -1; return; }
        if (hipFuncSetAttribute((const void*)mk_fwd, hipFuncAttributeMaxDynamicSharedMemorySize, LDS_BYTES) != hipSuccess) { fprintf(stderr, "kernel_launch: hipFuncSetAttribute failed\n"); grid = -1; return; }
        if (hipOccupancyMaxActiveBlocksPerMultiprocessor(&per_cu, (const void*)mk_fwd, NTHR, LDS_BYTES) != hipSuccess || per_cu < 1) fprintf(stderr, "kernel_launch: occupancy query reports %d\n", per_cu);
        (void)hipGetLastError();
        if (cus != NWG) { fprintf(stderr, "kernel_launch: built for %d CUs, device has %d\n", NWG, cus); grid = -1; return; }
        grid = NWG;
    }
    if (grid < 0) return;
    (void)hipMemsetAsync((char*)d_ws + WS_CTL, 0, CTL_ZERO_BYTES, stream);
    Params p{};
    for (int i = 0; i < 16; ++i) p.in[i] = (const float*)d_in[i];
    p.out = (float*)d_out; p.ws = (unsigned char*)d_ws; p.lo = 0; p.hi = NPHASE;
#if !MK_DEBUG
    hipLaunchKernelGGL(mk_fwd, dim3(grid), dim3(NTHR), LDS_BYTES, stream, p);
#else
    int pc = 0;
    auto run = [&](int kind, int l, int a0) { p.lo = pc; p.hi = pc + 1; hipLaunchKernelGGL(mk_fwd, dim3(grid), dim3(NTHR), LDS_BYTES, stream, p);
        if (kind != K_P0 && kind != K_LNM) hipLaunchKernelGGL(mk_check, dim3(4), dim3(256), 0, stream, p, kind, l, a0, pc); ++pc; };
    run(K_P0, 0, 0);
    for (int pr = 0; pr < 2; ++pr) for (int q = 0; q < 2; ++q) { const int l = 2 * pr + q;
        if (pr == 0) { run(K_GIN, l, 0); run(K_CONV, l, 0); run(K_RESA, l, 0); } else { run(K_QKV, l, 0); run(K_ATT, l, 0); run(K_COMB, l, 0); run(K_RESB, l, 0); }
        run(q == 0 ? K_LN0 : K_LN1, l, 0);
        if (q == 0) { for (int hf = 0; hf < 2; ++hf) { run(K_GU, l, hf); run(K_DN, l, hf); } run(K_LNF, l, 0); }
        else { run(K_SCAT, l, 0); for (int c = 0; c < NCHUNK; ++c) { run(K_MGU, l, c); run(K_MDN, l, c); } run(K_LNM, l, 0); } }
    if (pc != NPHASE) fprintf(stderr, "kernel_launch: debug phase enumeration mismatch %d\n", pc);
    hipLaunchKernelGGL(mk_report, dim3(1024), dim3(256), 0, stream, (float*)d_out, (const unsigned*)((char*)d_ws + WS_CTL) + CW_DBG);
#endif
}
```

```cpp
#include <hip/hip_runtime.h>
#include <cstdio>
#include <cstdint>

#ifndef MK_DEBUG
#define MK_DEBUG 0
#endif

namespace mk {
#define LAS __attribute__((address_space(3)))
typedef unsigned short bf16_t;
typedef short bf16x8 __attribute__((ext_vector_type(8)));
typedef short bf16x4 __attribute__((ext_vector_type(4)));
typedef float f32x4 __attribute__((ext_vector_type(4)));
typedef unsigned u32x4 __attribute__((ext_vector_type(4)));
typedef unsigned u32x2 __attribute__((ext_vector_type(2)));

constexpr int NB = 16, SEQ = 4096, D = 1024, M = NB * SEQ;
constexpr int DFF = 2816, NE = 8, DEX = 3584, ATTW = 512, NQ = 3 * ATTW, NKV = 6 * ATTW;
constexpr float ALPHA = 1.6817928305074292f;
constexpr float LN_EPS = 1e-5f;
constexpr int NWG = 256, NTHR = 512;
constexpr int NSLOT = 2 * M;
constexpr int CH_TILES = 128, NCHUNK = 4, CH_LAST = 136, TILE_CAP = 640;

constexpr size_t MiB = (size_t)1 << 20;
constexpr size_t WS_CTL = 0;
constexpr size_t CTL_ZERO_BYTES = 64 * 1024;
constexpr int CW_BAR = 1024;
constexpr int CW_DBG = 8192;
constexpr size_t CTL_CNT = 64 * 1024;
constexpr size_t CTL_TAB = 80 * 1024;
constexpr size_t CTL_META = 96 * 1024;
constexpr size_t WS_SMALL = 1 * MiB;
constexpr size_t WS_WIN = WS_SMALL, WS_WOUT = WS_SMALL + 12 * MiB, WS_WQKV2 = WS_SMALL + 16 * MiB, WS_WQ3 = WS_SMALL + 25 * MiB, WS_WO = WS_SMALL + 28 * MiB,
                 WS_WGU = WS_SMALL + 30 * MiB, WS_WDN = WS_SMALL + 52 * MiB;
constexpr size_t SZ_WIN = (size_t)3 * D * D * 2, SZ_WOUT = (size_t)D * D * 2, SZ_WO = (size_t)D * ATTW * 2, SZ_WGU = (size_t)2 * DFF * D * 2, SZ_WDN = (size_t)D * DFF * 2;
constexpr size_t WS_WM = 65 * MiB;
constexpr size_t SZ_WMGU = (size_t)NE * 2 * DEX * D * 2;
constexpr size_t WS_XA = 233 * MiB;
constexpr size_t WS_ROUTE = 361 * MiB;
constexpr size_t RT_TOKE = 0, RT_TOKG = 512 * 1024, RT_TOKR = 1024 * 1024, RT_SLOTT = 1536 * 1024, RT_SLOTG = 2048 * 1024 + 4096, RT_TOKS = 2560 * 1024 + 8192;
constexpr size_t WS_BIG = 365 * MiB;
constexpr size_t BG_CU = 0, BG_GB = 128 * MiB, BG_G = 256 * MiB;
constexpr size_t BG_K = 0, BG_V = 192 * MiB  , BG_OG = 384 * MiB, BG_LSE = 576 * MiB, BG_YATT = 384 * MiB;
constexpr size_t BG_HH = 384 * MiB;
constexpr size_t BG_HC = 0, BG_Y2 = 238 * MiB;
constexpr int XROW = 73728;
static_assert((size_t)XROW * DEX * 2 >= 494 * MiB && (size_t)(XROW + 8 * 256) * DEX * 2 <= 640 * MiB, "extra-tile region");
constexpr size_t WS_NEED = WS_BIG + 640 * MiB;
constexpr size_t DO_Q = 0, DO_O = 192 * MiB;

typedef float f32x2c __attribute__((ext_vector_type(2)));
typedef __bf16 bf16x2c __attribute__((ext_vector_type(2)));
__device__ __forceinline__ unsigned cvt_pk_bf16(float lo, float hi) { const f32x2c v = {lo, hi}; return __builtin_bit_cast(unsigned, __builtin_convertvector(v, bf16x2c)); }
__device__ __forceinline__ float bf_lo(unsigned w) { return __uint_as_float(w << 16); }
__device__ __forceinline__ float bf_hi(unsigned w) { return __uint_as_float(w & 0xffff0000u); }
__device__ __forceinline__ int ld_agent(const int* p) { return __hip_atomic_load(p, __ATOMIC_RELAXED, __HIP_MEMORY_SCOPE_AGENT); }
__device__ __forceinline__ int opaque_tid() { int t = threadIdx.x; asm volatile("" : "+v"(t)); return t; }
__device__ __forceinline__ int opq_i(int v) { asm volatile("" : "+s"(v)); return v; }
template <class T> __device__ __forceinline__ T* opq(T* p) { asm volatile("" : "+s"(p)); return p; }
__device__ __forceinline__ float wave_sum(float v) {
    v += __builtin_bit_cast(float, __builtin_amdgcn_update_dpp(0, __builtin_bit_cast(int, v), 0xB1, 0xf, 0xf, true));
    v += __builtin_bit_cast(float, __builtin_amdgcn_update_dpp(0, __builtin_bit_cast(int, v), 0x4E, 0xf, 0xf, true));
    v += __builtin_bit_cast(float, __builtin_amdgcn_update_dpp(0, __builtin_bit_cast(int, v), 0x141, 0xf, 0xf, true));
    v += __builtin_bit_cast(float, __builtin_amdgcn_update_dpp(0, __builtin_bit_cast(int, v), 0x140, 0xf, 0xf, true));
    v += __builtin_bit_cast(float, __builtin_amdgcn_update_dpp(0, __builtin_bit_cast(int, v), 0x142, 0xa, 0xf, false));
    v += __builtin_bit_cast(float, __builtin_amdgcn_update_dpp(0, __builtin_bit_cast(int, v), 0x143, 0xc, 0xf, false));
    return __builtin_bit_cast(float, __builtin_amdgcn_readlane(__builtin_bit_cast(int, v), 63));
}
__device__ __forceinline__ float shx(float v, int o, int lane) { return __builtin_bit_cast(float, __builtin_amdgcn_ds_bpermute((lane ^ o) << 2, __builtin_bit_cast(int, v))); }

#define XB_TMO      128
#define XB_XCNT(j)  (256  + 64 * (j))
#define XB_XSUB(j)  (1280 + 64 * (j))
#define XB_XGEN(j)  (2304 + 64 * (j))
#define XB_TOP      3328
#define XB_TOPGEN   3392
#define XCD_BAR_WORDS 3456
#define XB_SPIN_CAP (1u << 18)
__device__ __forceinline__ unsigned xb_ld(unsigned* p)              { return __hip_atomic_load(p, __ATOMIC_RELAXED, __HIP_MEMORY_SCOPE_AGENT); }
__device__ __forceinline__ unsigned xb_add(unsigned* p, unsigned v) { return __hip_atomic_fetch_add(p, v, __ATOMIC_RELAXED, __HIP_MEMORY_SCOPE_AGENT); }
__device__ __forceinline__ unsigned xb_xcc_id() { return (unsigned)__builtin_amdgcn_s_getreg((3 << 11) | 20) & 0xFu; }
#define XB_SPIN(cond, bar) do { unsigned _sp = 0; while (cond) { __builtin_amdgcn_s_sleep(1); \
    if ((++_sp & 255u) == 0u) { if (xb_ld(&(bar)[XB_TMO])) break; if (_sp > XB_SPIN_CAP) { atomicAdd(&(bar)[XB_TMO], 1u); break; } } } } while (0)
struct XcdBarrier { unsigned* bar; unsigned x; volatile LAS unsigned* st; };
__device__ __forceinline__ XcdBarrier xcd_barrier_post(unsigned* bar, volatile LAS unsigned* st) {
    XcdBarrier b; b.bar = bar; b.x = xb_xcc_id(); b.st = st;
    if (threadIdx.x == 0) (void)xb_add(&bar[XB_XCNT(b.x)], 1u);
    return b;
}
__device__ __forceinline__ void xcd_barrier_complete(unsigned* bar, unsigned x, unsigned& nloc, unsigned& nx) {
    const unsigned G = gridDim.x * gridDim.y * gridDim.z;
    unsigned sum, cnt, mine, sp = 0u;
    for (;;) {
        sum = 0u; cnt = 0u; mine = 0u;
#pragma unroll
        for (unsigned j = 0; j < 16; ++j) { const unsigned c = xb_ld(&bar[XB_XCNT(j)]); sum += c; cnt += (c > 0u) ? 1u : 0u; mine = (j == x) ? c : mine; }
        if (sum == G) break;
        __builtin_amdgcn_s_sleep(1);
        if ((++sp & 255u) == 0u) { if (xb_ld(&bar[XB_TMO])) break; if (sp > XB_SPIN_CAP) { atomicAdd(&bar[XB_TMO], 1u); break; } }
    }
    nloc = mine > 0u ? mine : 1u; nx = cnt > 0u ? cnt : 1u;
}
__device__ __forceinline__ void xcd_barrier(const XcdBarrier& b) {
    asm volatile("s_waitcnt vmcnt(0)" ::: "memory");
    __syncthreads();
    if (threadIdx.x == 0) {
        unsigned* bar = b.bar;
        __builtin_amdgcn_s_waitcnt(0);
        unsigned nloc = b.st[0], nx = b.st[1];
        if (nloc == 0u) { xcd_barrier_complete(bar, b.x, nloc, nx); b.st[0] = nloc; b.st[1] = nx; }
        const unsigned old = xb_add(&bar[XB_XSUB(b.x)], 1u);
        const unsigned gen = old / nloc;
        if (old + 1u == (gen + 1u) * nloc) {
            __builtin_amdgcn_fence(__ATOMIC_RELEASE, "agent");
            asm volatile("s_waitcnt vmcnt(0)" ::: "memory");
            const unsigned og = xb_add(&bar[XB_TOP], 1u);
            const unsigned tg = og / nx;
            if (og + 1u == (tg + 1u) * nx) xb_add(&bar[XB_TOPGEN], 1u);
            else XB_SPIN(xb_ld(&bar[XB_TOPGEN]) == tg, bar);
            __builtin_amdgcn_fence(__ATOMIC_ACQUIRE, "agent");
            xb_add(&bar[XB_XGEN(b.x)], 1u);
            asm volatile("s_waitcnt vmcnt(0)" ::: "memory");
        } else {
            XB_SPIN(xb_ld(&bar[XB_XGEN(b.x)]) == gen, bar);
            __builtin_amdgcn_fence(__ATOMIC_ACQUIRE, "agent");
            asm volatile("s_waitcnt vmcnt(0)" ::: "memory");
        }
    }
    __syncthreads();
}

#ifndef MOE_WGM
#define MOE_WGM 8
#endif
constexpr int BM = 256, BK = 64, HALF = 128, HTB = HALF * BK * 2, STAGE_BYTES = 8 * HTB, NXCD = 8, WGM = 4;
__device__ __forceinline__ int lds_byte(int r, int c) { const int st = (r >> 4) * 2 + (c >> 5), rr = r & 15, cc = c & 31, ob = rr * 64 + cc * 2; return st * 1024 + (ob ^ (((ob >> 9) & 1) << 5)); }
__device__ __forceinline__ void stage_rc(int b, int& R, int& C) { const int st = b / 1024, sb = b % 1024, swz = sb ^ (((sb >> 9) & 1) << 5); R = (st >> 1) * 16 + swz / 64; C = (st & 1) * 32 + (swz % 64) / 2; }
__device__ __forceinline__ int perm32(int rho) { const int n = rho >> 4, i = rho & 15; return 8 * (i >> 2) + 4 * n + (i & 3); }

struct Unit { int arow, brow, orow, pn, lo, hi; };
struct Gemm { const bf16_t* A; const bf16_t* Bt; int K; };

struct DenseOrder {
    static constexpr bool GATHER = false; __device__ __forceinline__ const int* gidx() const { return nullptr; }
    int nM, nN, nwg, G, c, row_base;
    __device__ __forceinline__ void init(int Mrows, int N, int G_, int c_, int row_base_) { nM = Mrows / BM; nN = N / BM; nwg = nM * nN; G = G_; c = c_; row_base = row_base_; }
    __device__ __forceinline__ bool next(int i, Unit& u) const {
        const long L = (long)i * G + c; if (L >= nwg) return false;
        int wgid = (int)L; { const int q = nwg / NXCD, r = nwg % NXCD, xcd = wgid % NXCD, off = wgid / NXCD; wgid = (xcd < r ? xcd * (q + 1) : r * (q + 1) + (xcd - r) * q) + off; }
        const int nig = WGM * nN, gid = wgid / nig, fm = gid * WGM, gsz = (nM - fm) < WGM ? (nM - fm) : WGM;
        const int pm = fm + ((wgid % nig) % gsz), pn = (wgid % nig) / gsz;
        u.arow = pm * BM; u.brow = pn * BM; u.orow = row_base + pm * BM; u.pn = pn; u.lo = 0; u.hi = BM; return true;
    }
};
template <bool GA>
struct MoeOrder {
    static constexpr bool GATHER = GA; const int* gix; __device__ __forceinline__ const int* gidx() const { return gix; }
    const LAS int* tab; int nt, nN, G, c, row0c, brows, down;
    int xt, row0x;
    int H;
    __device__ __forceinline__ bool next(int i, Unit& u) const {
        const int nwg = nt * nN; int L0 = i * G + c;
        if (H > 0) { const int NR = nwg / G;
            if (c < H) { if (i >= NR - 3) return false; }
            else if (i >= NR) { const int cp = c - H; if (i > NR || cp >= 3 * H) return false; const int q = (cp >= H ? 1 : 0) + (cp >= 2 * H ? 1 : 0); L0 = (NR - 3 + q) * G + (cp - q * H); } }
        if (L0 >= nwg) return false;
        int L = L0; { const int q = nwg / NXCD, r = nwg % NXCD, xcd = L % NXCD, off = L / NXCD; L = (xcd < r ? xcd * (q + 1) : r * (q + 1) + (xcd - r) * q) + off; }
        constexpr int MG = MOE_WGM; const int nig = MG * nN, gid = L / nig, fm = gid * MG, gsz = (nt - fm) < MG ? (nt - fm) : MG, w = L % nig;
        const int tl = fm + w % gsz, pn = w / gsz;
        const LAS int* tt = tab + 4 * tl;
        const int e = __builtin_amdgcn_readfirstlane(tt[0]), row0 = __builtin_amdgcn_readfirstlane(tt[1]);
        u.lo = __builtin_amdgcn_readfirstlane(tt[2]); u.hi = __builtin_amdgcn_readfirstlane(tt[3]);
        u.pn = pn; u.brow = e * brows + pn * BM;
        const int rc = tl >= xt ? row0x : row0c;
        if (!down) { u.arow = row0; u.orow = row0 - rc; } else { u.arow = row0 - rc; u.orow = row0; }
        return true;
    }
};

#define EPI_ROWS(ai, m) ((ai) * HALF + wr * 64 + (m) * 16 + fr)
__device__ __forceinline__ u32x4 pack8(const f32x4& a, const f32x4& b) { u32x4 w; w.x = cvt_pk_bf16(a[0], a[1]); w.y = cvt_pk_bf16(a[2], a[3]); w.z = cvt_pk_bf16(b[0], b[1]); w.w = cvt_pk_bf16(b[2], b[3]); return w; }
__device__ __forceinline__ float silu(float x) { return x * __builtin_amdgcn_rcpf(1.0f + __builtin_amdgcn_exp2f(-1.4426950408889634f * x)); }

struct EpiResid {
    bf16_t* Y; const bf16_t* X;
    __device__ __forceinline__ void operator()(const f32x4 (&acc)[2][2][4][2], const Unit& u, int wr, int wc, int fr, int fq) const {
        const int col0 = u.pn * BM + wc * 32 + 8 * fq;
#pragma unroll
        for (int ai = 0; ai < 2; ++ai)
#pragma unroll
            for (int m = 0; m < 4; ++m) { const size_t off = (size_t)(u.orow + EPI_ROWS(ai, m)) * D + col0;
#pragma unroll
                for (int bj = 0; bj < 2; ++bj) { const u32x4 xv = *(const u32x4*)(X + off + bj * HALF); const f32x4 a0 = acc[ai][bj][m][0], a1 = acc[ai][bj][m][1];
                    f32x4 o0, o1; o0[0] = ALPHA * bf_lo(xv.x) + a0[0]; o0[1] = ALPHA * bf_hi(xv.x) + a0[1]; o0[2] = ALPHA * bf_lo(xv.y) + a0[2]; o0[3] = ALPHA * bf_hi(xv.y) + a0[3];
                    o1[0] = ALPHA * bf_lo(xv.z) + a1[0]; o1[1] = ALPHA * bf_hi(xv.z) + a1[1]; o1[2] = ALPHA * bf_lo(xv.w) + a1[2]; o1[3] = ALPHA * bf_hi(xv.w) + a1[3];
                    *(u32x4*)(Y + off + bj * HALF) = pack8(o0, o1); }
                asm volatile("" ::: "memory"); }
    }
};
struct EpiSwiGLU {
    bf16_t* H; int ldh;
    __device__ __forceinline__ void operator()(const f32x4 (&acc)[2][2][4][2], const Unit& u, int wr, int wc, int fr, int fq) const {
        const int col0 = u.pn * HALF + wc * 32 + 8 * fq;
#pragma unroll
        for (int ai = 0; ai < 2; ++ai)
#pragma unroll
            for (int m = 0; m < 4; ++m) { const int r = EPI_ROWS(ai, m);
                if (r >= u.lo && r < u.hi) { f32x4 h0, h1;
#pragma unroll
                    for (int j = 0; j < 4; ++j) { h0[j] = silu(acc[ai][0][m][0][j]) * acc[ai][1][m][0][j]; h1[j] = silu(acc[ai][0][m][1][j]) * acc[ai][1][m][1][j]; }
                    *(u32x4*)(H + (size_t)(u.orow + r) * ldh + col0) = pack8(h0, h1); } }
    }
};
struct EpiCU {
    bf16_t* CU; bf16_t* GB;
    __device__ __forceinline__ void operator()(const f32x4 (&acc)[2][2][4][2], const Unit& u, int wr, int wc, int fr, int fq) const {
        if (u.pn < 8) { const int col0 = u.pn * HALF + wc * 32 + 8 * fq;
#pragma unroll
            for (int ai = 0; ai < 2; ++ai)
#pragma unroll
                for (int m = 0; m < 4; ++m) { const f32x4 c0 = acc[ai][0][m][0] * acc[ai][1][m][0], c1 = acc[ai][0][m][1] * acc[ai][1][m][1];
                    *(u32x4*)(CU + (size_t)(u.orow + EPI_ROWS(ai, m)) * D + col0) = pack8(c0, c1); }
        } else { const int col0 = (u.pn - 8) * BM + wc * 32 + 8 * fq;
#pragma unroll
            for (int ai = 0; ai < 2; ++ai)
#pragma unroll
                for (int m = 0; m < 4; ++m)
#pragma unroll
                    for (int bj = 0; bj < 2; ++bj) *(u32x4*)(GB + (size_t)(u.orow + EPI_ROWS(ai, m)) * D + col0 + bj * HALF) = pack8(acc[ai][bj][m][0], acc[ai][bj][m][1]);
        }
    }
};
__device__ __forceinline__ size_t resid_off(int token, int g, int h, int e) {
    const int b = token >> 12, s = token & 4095, sh = 2 * g, rr = s & ((1 << sh) - 1), i = s >> sh, L = 4096 >> sh;
    return ((size_t)((b * 3 + g) * 8 + h) * 4096 + (size_t)rr * L + i) * 64 + e;
}
struct EpiQKV {
    bf16_t *Q, *KV;
    __device__ __forceinline__ void operator()(const f32x4 (&acc)[2][2][4][2], const Unit& u, int wr, int wc, int fr, int fq) const {
#pragma unroll
        for (int bj = 0; bj < 2; ++bj) { const int cw = u.pn * BM + bj * HALF + wc * 32;
            const bool isq = cw < NQ; const int c2 = cw - NQ;
            const int g = isq ? (cw >> 9) : (c2 >> 10), h = isq ? ((cw >> 6) & 7) : ((c2 >> 6) & 7);
            bf16_t* dst = KV + (size_t)((c2 >> 9) & 1) * ((size_t)M * 1536); if (isq) dst = Q;
            const int e0 = (cw & 63) + 8 * fq, sh = 2 * g, L = 4096 >> sh;
#pragma unroll
            for (int ai = 0; ai < 2; ++ai)
#pragma unroll
                for (int m = 0; m < 4; ++m) { const int token = u.orow + EPI_ROWS(ai, m), b = token >> 12, s = token & 4095, rr = s & ((1 << sh) - 1), i = s >> sh;
                    *(u32x4*)(dst + ((size_t)((b * 3 + g) * 8 + h) * 4096 + (size_t)(rr * L + i)) * 64 + e0) = pack8(acc[ai][bj][m][0], acc[ai][bj][m][1]);
                    asm volatile("" ::: "memory"); }
        }
    }
};
struct EpiMoeDown {
    bf16_t* Y2; const int* slot_tok; const float* slot_gate;
    __device__ __forceinline__ void operator()(const f32x4 (&acc)[2][2][4][2], const Unit& u, int wr, int wc, int fr, int fq) const {
        const int col0 = u.pn * BM + wc * 32 + 8 * fq;
#pragma unroll
        for (int ai = 0; ai < 2; ++ai)
#pragma unroll
            for (int m = 0; m < 4; ++m) { const int r = EPI_ROWS(ai, m);
                if (r >= u.lo && r < u.hi) { const int ent = slot_tok[u.orow + r]; const float gt = slot_gate[u.orow + r];
                    bf16_t* rowp = Y2 + ((size_t)(ent & 1) * M + (ent >> 1)) * D + col0;
#pragma unroll
                    for (int bj = 0; bj < 2; ++bj) *(u32x4*)(rowp + bj * HALF) = pack8(acc[ai][bj][m][0] * gt, acc[ai][bj][m][1] * gt); } }
    }
};

__device__ __forceinline__ int moe_tab_to_lds(const int* gtab, int t0, int nt, LAS int* ltab) {
    const int tid = opaque_tid();
    for (int i = tid; i < 4 * nt; i += NTHR) ltab[i] = ld_agent(gtab + 4 * t0 + i);
    const int row0c = __builtin_amdgcn_readfirstlane(ld_agent(gtab + 4 * t0 + 1));
    __syncthreads();
    return row0c;
}
struct NoHook { static constexpr bool ON = false; __device__ __forceinline__ void step(int) {} };
constexpr int TRH_GU = (D / 64) * (2 * DEX / 64), TRH_DN = (DEX / 64) * (D / 64), TRH_E = TRH_GU + TRH_DN, TRH_ALL = NE * TRH_E;
struct TrMoeHook {
    static constexpr bool ON = true;
    const float* mg; long long dmu; const float* md; bf16_t* wgu; bf16_t* wdn; int it;
    __device__ __forceinline__ void step(int lane) {
        if (it < TRH_ALL) {
            const int e = it / TRH_E, r = it - e * TRH_E;
            const float* src; bf16_t* dst; int ldw, K;
            if (r < TRH_GU) { const int kb = r / (2 * DEX / 64), rb = r - kb * (2 * DEX / 64), t = rb >> 2, sub = rb & 3;
                src = (const float*)((const char*)mg + (sub < 2 ? 0ll : dmu)) + (size_t)e * D * DEX + 128 * t + 64 * (sub & 1) + (size_t)(64 * kb) * DEX; ldw = DEX; K = D;
                dst = wgu + (size_t)e * 2 * DEX * D + (size_t)(64 * rb) * D + 64 * kb; }
            else { const int r2 = r - TRH_GU, kb = r2 / (D / 64), nb = r2 - kb * (D / 64);
                src = md + (size_t)e * DEX * D + (size_t)(64 * kb) * D + 64 * nb; ldw = D; K = DEX;
                dst = wdn + (size_t)e * D * DEX + (size_t)(64 * nb) * DEX + 64 * kb; }
            float v[64];
            const float* sp = src + lane;
#pragma unroll
            for (int k = 0; k < 64; ++k) v[k] = __builtin_nontemporal_load(sp + (size_t)k * ldw);
            bf16_t* dp = dst + (size_t)lane * K;
#pragma unroll
            for (int j = 0; j < 8; ++j) { u32x4 o; o.x = cvt_pk_bf16(v[8 * j], v[8 * j + 1]); o.y = cvt_pk_bf16(v[8 * j + 2], v[8 * j + 3]); o.z = cvt_pk_bf16(v[8 * j + 4], v[8 * j + 5]); o.w = cvt_pk_bf16(v[8 * j + 6], v[8 * j + 7]);
                *(u32x4*)(dp + 8 * j) = o; }
        }
        it += NWG * 8;
    }
};
template <class Epi, class Sched, class Hook>
__device__ __forceinline__ void gemm_phase(LAS unsigned char* lds, const Gemm g, const Sched& S, const Epi& E, Hook& X) {
    const int tid = opaque_tid(), wid = __builtin_amdgcn_readfirstlane(tid >> 6), lane = tid & 63, wr = wid >> 2, wc = wid & 3, fr = lane & 15, fq = lane >> 4;
    const int K = g.K, nt = K / BK;
    unsigned voffA[2], voffB[2];
#pragma unroll
    for (int i = 0; i < 2; ++i) { int R, C; stage_rc(tid * 16 + i * 8192, R, C); const int Rb = (R & ~31) + perm32(R & 31);
        voffA[i] = (unsigned)(R * K + C) * 2u; voffB[i] = (unsigned)(Rb * K + C) * 2u; }
    const size_t kstep = (size_t)(BK * 2);
    const size_t hstep = (size_t)HALF * K * 2;
    const size_t rstep = (size_t)K * 2;
    const unsigned ldsw = (unsigned)wid * 1024u;
    const int aoff = lds_byte(wr * 64 + fr, fq * 8), boff = lds_byte(wc * 32 + fr, fq * 8);
#define PG8_SA(b, h) (((b) * 2 + (h)) * HTB)
#define PG8_SB(b, h) ((4 + (b) * 2 + (h)) * HTB)
#define PG8_STAGE(bufoff, gbase, voff) do { _Pragma("unroll") for (int _i = 0; _i < 2; ++_i) \
        __builtin_amdgcn_global_load_lds((const unsigned*)((const char*)(gbase) + (voff)[_i]), (LAS unsigned*)(lds + (bufoff) + ldsw + _i * 8192), 16, 0, 0); } while (0)
#define PG8_LDA(dst, b, h) do { _Pragma("unroll") for (int m = 0; m < 4; ++m) _Pragma("unroll") for (int k = 0; k < 2; ++k) dst[m][k] = *(const LAS bf16x8*)(lds + PG8_SA(b, h) + aoff + m * 2048 + k * 1024); } while (0)
#define PG8_LDB(dst, b, h) do { _Pragma("unroll") for (int n = 0; n < 2; ++n) _Pragma("unroll") for (int k = 0; k < 2; ++k) dst[n][k] = *(const LAS bf16x8*)(lds + PG8_SB(b, h) + boff + n * 2048 + k * 1024); } while (0)
#define PG8_MMA(ai, bj, At, Bt) do { __builtin_amdgcn_s_setprio(1); _Pragma("unroll") for (int m = 0; m < 4; ++m) _Pragma("unroll") for (int n = 0; n < 2; ++n) _Pragma("unroll") for (int k = 0; k < 2; ++k) \
        acc[ai][bj][m][n] = __builtin_amdgcn_mfma_f32_16x16x32_bf16(Bt[n][k], At[m][k], acc[ai][bj][m][n], 0, 0, 0); __builtin_amdgcn_s_setprio(0); } while (0)
#define PG8_WAIT_V(n) asm volatile("s_waitcnt vmcnt(" #n ")" ::: "memory")
#define PG8_WAIT_L(n) asm volatile("s_waitcnt lgkmcnt(" #n ")" ::: "memory")
#define PG8_BAR __builtin_amdgcn_s_barrier()
#define PG8_SCHED __builtin_amdgcn_sched_barrier(0)
    constexpr bool GA = Sched::GATHER;
    unsigned vA[2][2];
#define PG8_GSLOT(h, i) (lds + STAGE_BYTES + ((h) * 2 + (i)) * 2048 + wid * 256)
#define PG8_GDMA(u_) do { _Pragma("unroll") for (int _i = 0; _i < 2; ++_i) { int R_, C_; stage_rc(tid * 16 + _i * 8192, R_, C_); _Pragma("unroll") for (int _h = 0; _h < 2; ++_h) \
        __builtin_amdgcn_global_load_lds((const unsigned*)(S.gidx() + ((u_).arow + _h * HALF + R_)), (LAS unsigned*)PG8_GSLOT(_h, _i), 4, 0, 0); } } while (0)
#define PG8_GOFF_G(u_) do { _Pragma("unroll") for (int _i = 0; _i < 2; ++_i) { int R_, C_; stage_rc(tid * 16 + _i * 8192, R_, C_); _Pragma("unroll") for (int _h = 0; _h < 2; ++_h) \
        vA[_h][_i] = ((unsigned)(S.gidx()[(u_).arow + _h * HALF + R_] >> 1) * (unsigned)K + (unsigned)C_) * 2u; } } while (0)
#define PG8_GOFF_L() do { _Pragma("unroll") for (int _i = 0; _i < 2; ++_i) { int R_, C_; stage_rc(tid * 16 + _i * 8192, R_, C_); _Pragma("unroll") for (int _h = 0; _h < 2; ++_h) \
        vA[_h][_i] = ((unsigned)(*(const LAS int*)(PG8_GSLOT(_h, _i) + lane * 4) >> 1) * (unsigned)K + (unsigned)C_) * 2u; } } while (0)
#define PG8_STAGE_A(bufoff, gbase, h) do { if (GA) PG8_STAGE(bufoff, gbase, vA[h]); else PG8_STAGE(bufoff, (gbase) + (h) * hstep, voffA); } while (0)
    Unit cur, nxt, nn; int ui = 0;
    if (!S.next(0, cur)) return;
    bool has_next = S.next(1, nxt);
    if (GA) { PG8_GOFF_G(cur); if (has_next) PG8_GDMA(nxt); else PG8_GDMA(cur); }
    f32x4 acc[2][2][4][2];
#pragma unroll
    for (int a = 0; a < 2; ++a)
#pragma unroll
        for (int b = 0; b < 2; ++b)
#pragma unroll
            for (int m = 0; m < 4; ++m)
#pragma unroll
                for (int n = 0; n < 2; ++n) acc[a][b][m][n] = (f32x4){0.f, 0.f, 0.f, 0.f};
    bf16x8 At[4][2], B0[2][2], B1[2][2];
    const char* cA = (const char*)g.A + (GA ? (size_t)0 : (size_t)cur.arow * rstep); const char* cB = (const char*)g.Bt + (size_t)cur.brow * rstep;
    PG8_STAGE(PG8_SB(0, 0), cB, voffB); PG8_STAGE(PG8_SB(0, 1), cB + hstep, voffB); PG8_STAGE_A(PG8_SA(0, 0), cA, 0); PG8_STAGE_A(PG8_SA(0, 1), cA, 1);
    if (wr == 1) PG8_BAR;
    PG8_WAIT_V(2); PG8_BAR;
    PG8_STAGE(PG8_SB(1, 0), cB + kstep, voffB); PG8_STAGE_A(PG8_SA(1, 0), cA + kstep, 0); PG8_STAGE(PG8_SB(1, 1), cB + hstep + kstep, voffB);
    PG8_WAIT_V(6); PG8_BAR;
    for (;;) {
        const char* nA = (has_next && !GA) ? (const char*)g.A + (size_t)nxt.arow * rstep : cA; const char* nB = has_next ? (const char*)g.Bt + (size_t)nxt.brow * rstep : cB;
        for (int t = 0; t < nt; t += 2) {
            const bool last = (t == nt - 2);
            const char* a1 = cA + (size_t)(t + 1) * kstep;
            const char* a2 = last ? nA : cA + (size_t)(t + 2) * kstep; const char* b2 = last ? nB : cB + (size_t)(t + 2) * kstep;
            const char* a3 = a2 + kstep; const char* b3 = b2 + kstep;
            PG8_LDB(B0, 0, 0); PG8_LDB(B1, 0, 1); PG8_SCHED; PG8_LDA(At, 0, 0); PG8_STAGE_A(PG8_SA(1, 1), a1, 1);
            PG8_WAIT_V(8); PG8_WAIT_L(0); PG8_BAR; PG8_MMA(0, 0, At, B0); PG8_MMA(0, 1, At, B1); PG8_BAR; PG8_SCHED;
            PG8_LDA(At, 0, 1); PG8_STAGE(PG8_SB(0, 0), b2, voffB); PG8_STAGE(PG8_SB(0, 1), b2 + hstep, voffB);
            if (GA && last) PG8_GOFF_L();
            PG8_STAGE_A(PG8_SA(0, 0), a2, 0);
            PG8_WAIT_V(8); PG8_WAIT_L(0); PG8_BAR; PG8_MMA(1, 0, At, B0); PG8_MMA(1, 1, At, B1); PG8_BAR; PG8_SCHED;
            PG8_LDB(B0, 1, 0); PG8_LDB(B1, 1, 1); PG8_SCHED; PG8_LDA(At, 1, 0); PG8_STAGE_A(PG8_SA(0, 1), a2, 1);
            PG8_WAIT_V(8); PG8_WAIT_L(0); PG8_BAR; PG8_MMA(0, 0, At, B0); PG8_MMA(0, 1, At, B1); PG8_BAR; PG8_SCHED;
            PG8_LDA(At, 1, 1); PG8_STAGE(PG8_SB(1, 0), b3, voffB); PG8_STAGE(PG8_SB(1, 1), b3 + hstep, voffB); PG8_STAGE_A(PG8_SA(1, 0), a3, 0);
            PG8_WAIT_V(8); PG8_WAIT_L(0); PG8_BAR; PG8_MMA(1, 0, At, B0); PG8_MMA(1, 1, At, B1); PG8_BAR; PG8_SCHED;
        }
        const bool has_nn = has_next && S.next(ui + 2, nn);
        if (GA) { if (has_nn) PG8_GDMA(nn); }
        if (wr == 0) PG8_BAR;
        E(acc, cur, wr, wc, fr, fq);
        if (Hook::ON) { __builtin_amdgcn_sched_barrier(0); X.step(lane); __builtin_amdgcn_sched_barrier(0); }
        if (!has_next) break;
#pragma unroll
        for (int a = 0; a < 2; ++a)
#pragma unroll
            for (int b = 0; b < 2; ++b)
#pragma unroll
                for (int m = 0; m < 4; ++m)
#pragma unroll
                    for (int n = 0; n < 2; ++n) acc[a][b][m][n] = (f32x4){0.f, 0.f, 0.f, 0.f};
        cur = nxt; nxt = nn; has_next = has_nn; cA = nA; cB = nB; ++ui;
        if (wr == 1) PG8_BAR;
    }
    PG8_WAIT_V(0);
    PG8_BAR;
#undef PG8_SA
#undef PG8_SB
#undef PG8_STAGE
#undef PG8_STAGE_A
#undef PG8_GSLOT
#undef PG8_GDMA
#undef PG8_GOFF_G
#undef PG8_GOFF_L
#undef PG8_LDA
#undef PG8_LDB
#undef PG8_MMA
#undef PG8_WAIT_V
#undef PG8_WAIT_L
#undef PG8_BAR
#undef PG8_SCHED
}
template <class Epi, class Sched>
__device__ __forceinline__ void gemm_phase(LAS unsigned char* lds, const Gemm g, const Sched& S, const Epi& E) { NoHook X; gemm_phase(lds, g, S, E, X); }

constexpr int LDS_MISC = 139264;
constexpr int LDS_BYTES = 147456;
constexpr int LDS_TAB = LDS_MISC + 64;
static_assert(LDS_TAB + CH_LAST * 16 <= LDS_BYTES, "LDS map");
constexpr int TR_PITCH = 65, TR_WAVE_BYTES = 64 * TR_PITCH * 4;
static_assert(8 * TR_WAVE_BYTES <= LDS_MISC && STAGE_BYTES <= LDS_MISC, "LDS map");

struct Params { const float* in[16]; float* out; unsigned char* ws; int lo, hi; };
enum { IN_X = 0, IN_AWIN, IN_ACONV, IN_AWOUT, IN_KVW, IN_BWQ, IN_BWO, IN_FG, IN_FU, IN_FD, IN_MR, IN_MG, IN_MU, IN_MD, IN_LNG, IN_LNB };

__device__ __forceinline__ void tr_item(const float* src, int ldw, bf16_t* dst, int K, LAS float* scr, int lane) {
    f32x4 v[16];
    const int q = lane >> 4, c4 = (lane & 15) * 4;
#pragma unroll
    for (int i = 0; i < 16; ++i) v[i] = *(const f32x4*)(src + (size_t)(4 * i + q) * ldw + c4);
#pragma unroll
    for (int i = 0; i < 16; ++i) { LAS float* s = scr + (4 * i + q) * TR_PITCH + c4; s[0] = v[i][0]; s[1] = v[i][1]; s[2] = v[i][2]; s[3] = v[i][3]; }
    asm volatile("s_waitcnt lgkmcnt(0)" ::: "memory");
    const int c = lane & 7;
#pragma unroll
    for (int j = 0; j < 8; ++j) { const int n = (lane >> 3) + 8 * j; const LAS float* s = scr + (8 * c) * TR_PITCH + n;
        u32x4 o; o.x = cvt_pk_bf16(s[0 * TR_PITCH], s[1 * TR_PITCH]); o.y = cvt_pk_bf16(s[2 * TR_PITCH], s[3 * TR_PITCH]); o.z = cvt_pk_bf16(s[4 * TR_PITCH], s[5 * TR_PITCH]); o.w = cvt_pk_bf16(s[6 * TR_PITCH], s[7 * TR_PITCH]);
        *(u32x4*)(dst + (size_t)n * K + 8 * c) = o; }
    asm volatile("s_waitcnt lgkmcnt(0)" ::: "memory");
}
__device__ __forceinline__ int tr_plain(int it, int NGW, const float* W, int ldw, int K, int ncols, bf16_t* dst, LAS float* scr, int lane) {
    const int ncb = ncols / 64, nit = (K / 64) * ncb;
    for (; it < nit; it += NGW) { const int kb = it / ncb, nb = it % ncb; tr_item(W + (size_t)(64 * kb) * ldw + 64 * nb, ldw, dst + (size_t)(64 * nb) * K + 64 * kb, K, scr, lane); }
    return it - nit;
}
__device__ __forceinline__ int tr_gu(int it, int NGW, const float* Wg, const float* Wu, int ldw, int K, int F, bf16_t* dst, LAS float* scr, int lane) {
    const int nrb = 2 * F / 64, nit = (K / 64) * nrb;
    for (; it < nit; it += NGW) { const int kb = it / nrb, rb = it % nrb, t = rb >> 2, sub = rb & 3;
        const float* W = (sub < 2 ? Wg : Wu) + 128 * t + 64 * (sub & 1);
        tr_item(W + (size_t)(64 * kb) * ldw, ldw, dst + (size_t)(64 * rb) * K + 64 * kb, K, scr, lane); }
    return it - nit;
}
__device__ __forceinline__ int tr_moe(int it, int NGW, const float* mg, const float* mu, const float* md, unsigned char* ws, LAS float* scr, int lane) {
    bf16_t* wgu = (bf16_t*)(ws + WS_WM); bf16_t* wdn = (bf16_t*)(ws + WS_WM + SZ_WMGU);
    for (int e = 0; e < NE; ++e) {
        it = tr_gu(it, NGW, mg + (size_t)e * D * DEX, mu + (size_t)e * D * DEX, DEX, D, DEX, wgu + (size_t)e * 2 * DEX * D, scr, lane);
        it = tr_plain(it, NGW, md + (size_t)e * DEX * D, D, DEX, D, wdn + (size_t)e * D * DEX, scr, lane);
    }
    return it;
}
__device__ __forceinline__ void p0_phase(const Params& p, LAS unsigned char* lds, int G, int bx) {
    const int tid = opaque_tid(), lane = tid & 63, wave = __builtin_amdgcn_readfirstlane(tid >> 6);
    LAS float* scr = (LAS float*)(lds + wave * TR_WAVE_BYTES);
    const int NGW = G * 8; int it = bx * 8 + wave;
    unsigned char* ws = p.ws;
    for (int l = 0; l < 2; ++l) {
        const float* win = p.in[IN_AWIN] + (size_t)l * D * 3 * D; bf16_t* d = (bf16_t*)(ws + WS_WIN + l * SZ_WIN);
        it = tr_gu(it, NGW, win + D, win + 2 * D, 3 * D, D, D, d, scr, lane);
        it = tr_plain(it, NGW, win, 3 * D, D, D, d + (size_t)2 * D * D, scr, lane);
        it = tr_plain(it, NGW, p.in[IN_AWOUT] + (size_t)l * D * D, D, D, D, (bf16_t*)(ws + WS_WOUT + l * SZ_WOUT), scr, lane);
        it = tr_plain(it, NGW, p.in[IN_BWO] + (size_t)l * ATTW * D, D, ATTW, D, (bf16_t*)(ws + WS_WO + l * SZ_WO), scr, lane);
        it = tr_gu(it, NGW, p.in[IN_FG] + (size_t)l * D * DFF, p.in[IN_FU] + (size_t)l * D * DFF, DFF, D, DFF, (bf16_t*)(ws + WS_WGU + l * SZ_WGU), scr, lane);
        it = tr_plain(it, NGW, p.in[IN_FD] + (size_t)l * DFF * D, D, DFF, D, (bf16_t*)(ws + WS_WDN + l * SZ_WDN), scr, lane);
    }
    it = tr_plain(it, NGW, p.in[IN_BWQ], NQ, D, NQ, (bf16_t*)(ws + WS_WQKV2), scr, lane);
    it = tr_plain(it, NGW, p.in[IN_KVW], NKV, D, NKV, (bf16_t*)(ws + WS_WQKV2) + (size_t)NQ * D, scr, lane);
    it = tr_plain(it, NGW, p.in[IN_BWQ] + (size_t)D * NQ, NQ, D, NQ, (bf16_t*)(ws + WS_WQ3), scr, lane);
    const f32x4* xs = (const f32x4*)p.in[IN_X]; u32x4* xd = (u32x4*)(ws + WS_XA);
    for (size_t i = (size_t)bx * NTHR + tid; i < (size_t)M * D / 8; i += (size_t)G * NTHR) { const f32x4 a = xs[2 * i], b = xs[2 * i + 1]; xd[i] = pack8(a, b); }
}

__device__ __forceinline__ void conv_phase(const bf16_t* CU, const bf16_t* GB, bf16_t* Gb, const float* cw, int G, int bx) {
    const int tid = opaque_tid(), ch = (tid & 127) * 8, sub = tid >> 7;
    float w0[8], w1[8], w2[8];
#pragma unroll
    for (int j = 0; j < 8; ++j) { w0[j] = cw[ch + j]; w1[j] = cw[D + ch + j]; w2[j] = cw[2 * D + ch + j]; }
    for (int blk = bx; blk < M / 256; blk += G) {
        const int m0 = blk * 256 + sub * 64;
        u32x4 p2 = (u32x4){0u, 0u, 0u, 0u}, p1 = p2;
        if ((m0 & (SEQ - 1)) != 0) { p2 = *(const u32x4*)(CU + (size_t)(m0 - 2) * D + ch); p1 = *(const u32x4*)(CU + (size_t)(m0 - 1) * D + ch); }
#pragma unroll 4
        for (int i = 0; i < 64; ++i) { const size_t off = (size_t)(m0 + i) * D + ch;
            const u32x4 c0 = *(const u32x4*)(CU + off), gv = *(const u32x4*)(GB + off);
            const unsigned a2[4] = {p2.x, p2.y, p2.z, p2.w}, a1[4] = {p1.x, p1.y, p1.z, p1.w}, a0[4] = {c0.x, c0.y, c0.z, c0.w}, gg[4] = {gv.x, gv.y, gv.z, gv.w};
            unsigned o[4];
#pragma unroll
            for (int j = 0; j < 4; ++j) {
                const float lo = bf_lo(gg[j]) * (w0[2 * j] * bf_lo(a2[j]) + w1[2 * j] * bf_lo(a1[j]) + w2[2 * j] * bf_lo(a0[j]));
                const float hi = bf_hi(gg[j]) * (w0[2 * j + 1] * bf_hi(a2[j]) + w1[2 * j + 1] * bf_hi(a1[j]) + w2[2 * j + 1] * bf_hi(a0[j]));
                o[j] = cvt_pk_bf16(lo, hi); }
            *(u32x4*)(Gb + off) = (u32x4){o[0], o[1], o[2], o[3]};
            p2 = p1; p1 = c0; }
    }
}

template <int MODE>
__device__ __forceinline__ void ln_phase(const Params& p, LAS unsigned char* lds, const bf16_t* Y, const float* gam, const float* bet, const float* wrt, int G, int bx) {
    const int tid = opaque_tid(), lane = tid & 63, wave = __builtin_amdgcn_readfirstlane(tid >> 6);
    unsigned char* ws = p.ws;
    bf16_t* xa = (bf16_t*)(ws + WS_XA);
    const bf16_t* y2 = (const bf16_t*)(ws + WS_BIG + BG_Y2);
    f32x4 gv[4], bv[4];
#pragma unroll
    for (int jj = 0; jj < 4; ++jj) { gv[jj] = *(const f32x4*)(gam + 4 * lane + 256 * jj); bv[jj] = *(const f32x4*)(bet + 4 * lane + 256 * jj); }
    float wr8[MODE == 1 ? 16 : 1][8];
    if (MODE == 1) {
#pragma unroll
        for (int jj = 0; jj < 4; ++jj)
#pragma unroll
            for (int ii = 0; ii < 4; ++ii) { const f32x4 a = *(const f32x4*)(wrt + (size_t)(4 * lane + 256 * jj + ii) * NE), b = *(const f32x4*)(wrt + (size_t)(4 * lane + 256 * jj + ii) * NE + 4);
                wr8[MODE == 1 ? jj * 4 + ii : 0][0] = a[0]; wr8[MODE == 1 ? jj * 4 + ii : 0][1] = a[1]; wr8[MODE == 1 ? jj * 4 + ii : 0][2] = a[2]; wr8[MODE == 1 ? jj * 4 + ii : 0][3] = a[3];
                wr8[MODE == 1 ? jj * 4 + ii : 0][4] = b[0]; wr8[MODE == 1 ? jj * 4 + ii : 0][5] = b[1]; wr8[MODE == 1 ? jj * 4 + ii : 0][6] = b[2]; wr8[MODE == 1 ? jj * 4 + ii : 0][7] = b[3]; }
    }
    LAS int* tabE = (LAS int*)lds;
    LAS float* tabG = (LAS float*)(lds + 2048);
    LAS int* wcnt = (LAS int*)(lds + 4096);
    for (int blk = bx; blk < M / 256; blk += G) {
        u32x2 pa[4], pb[4], pc[4];
#define LN_LOAD(rw) do { const size_t o_ = (size_t)(rw) * D + 4 * lane; _Pragma("unroll") for (int jj = 0; jj < 4; ++jj) { \
            if (MODE <= 1) pa[jj] = *(const u32x2*)(Y + o_ + 256 * jj); \
            else { pa[jj] = *(const u32x2*)(xa + o_ + 256 * jj); pb[jj] = *(const u32x2*)(y2 + o_ + 256 * jj); pc[jj] = *(const u32x2*)(y2 + (size_t)M * D + o_ + 256 * jj); } } } while (0)
        LN_LOAD((size_t)blk * 256 + wave * 32);
        for (int i = 0; i < 32; ++i) {
            const int rl = wave * 32 + i; const size_t row = (size_t)blk * 256 + rl;
            f32x4 v[4];
#pragma unroll
            for (int jj = 0; jj < 4; ++jj) {
                if (MODE <= 1) { v[jj][0] = bf_lo(pa[jj].x); v[jj][1] = bf_hi(pa[jj].x); v[jj][2] = bf_lo(pa[jj].y); v[jj][3] = bf_hi(pa[jj].y); }
                else { v[jj][0] = ALPHA * bf_lo(pa[jj].x) + (bf_lo(pb[jj].x) + bf_lo(pc[jj].x)); v[jj][1] = ALPHA * bf_hi(pa[jj].x) + (bf_hi(pb[jj].x) + bf_hi(pc[jj].x));
                       v[jj][2] = ALPHA * bf_lo(pa[jj].y) + (bf_lo(pb[jj].y) + bf_lo(pc[jj].y)); v[jj][3] = ALPHA * bf_hi(pa[jj].y) + (bf_hi(pb[jj].y) + bf_hi(pc[jj].y)); } }
            if (i + 1 < 32) LN_LOAD(row + 1);
            float s = 0.f;
#pragma unroll
            for (int jj = 0; jj < 4; ++jj) s += (v[jj][0] + v[jj][1]) + (v[jj][2] + v[jj][3]);
            const float mean = wave_sum(s) * (1.0f / D); float s2 = 0.f;
#pragma unroll
            for (int jj = 0; jj < 4; ++jj) { v[jj] = v[jj] - mean; s2 += (v[jj][0] * v[jj][0] + v[jj][1] * v[jj][1]) + (v[jj][2] * v[jj][2] + v[jj][3] * v[jj][3]); }
            const float rstd = 1.0f / sqrtf(wave_sum(s2) * (1.0f / D) + LN_EPS);
#pragma unroll
            for (int jj = 0; jj < 4; ++jj) v[jj] = v[jj] * rstd * gv[jj] + bv[jj];
            if (MODE == 3) {
#pragma unroll
                for (int jj = 0; jj < 4; ++jj) *(f32x4*)(p.out + row * D + 4 * lane + 256 * jj) = v[jj];
            } else {
#pragma unroll
                for (int jj = 0; jj < 4; ++jj) { u32x2 o; o.x = cvt_pk_bf16(v[jj][0], v[jj][1]); o.y = cvt_pk_bf16(v[jj][2], v[jj][3]); *(u32x2*)(xa + row * D + 4 * lane + 256 * jj) = o; }
            }
            if (MODE == 1) {
                float lg[8];
#pragma unroll
                for (int e = 0; e < 8; ++e) { float a = 0.f;
#pragma unroll
                    for (int jj = 0; jj < 4; ++jj)
#pragma unroll
                        for (int ii = 0; ii < 4; ++ii) a += v[jj][ii] * wr8[MODE == 1 ? jj * 4 + ii : 0][e];
                    lg[e] = wave_sum(a); }
                int b1 = 0; float v1 = lg[0];
#pragma unroll
                for (int e = 1; e < 8; ++e) if (lg[e] > v1) { v1 = lg[e]; b1 = e; }
                int b2 = -1; float v2 = 0.f;
#pragma unroll
                for (int e = 0; e < 8; ++e) if (e != b1 && (b2 < 0 || lg[e] > v2)) { v2 = lg[e]; b2 = e; }
                const float ex = __expf(v2 - v1), g1 = 1.0f / (1.0f + ex), g2 = ex * g1;
                if (lane == 0) { tabE[rl * 2] = b1; tabE[rl * 2 + 1] = b2; tabG[rl * 2] = g1; tabG[rl * 2 + 1] = g2; }
            }
        }
        if (MODE == 1) {
            __syncthreads();
            const int e = tabE[tid]; int rank = 0;
#pragma unroll
            for (int x = 0; x < 8; ++x) { const unsigned long long mk = __ballot(e == x); if (e == x) rank = __popcll(mk & ((1ull << lane) - 1ull)); if (lane == 0) wcnt[wave * 8 + x] = __popcll(mk); }
            __syncthreads();
            for (int j = 0; j < wave; ++j) rank += wcnt[j * 8 + e];
            const int ent = blk * 512 + tid;
            ((int*)(ws + WS_ROUTE + RT_TOKE))[ent] = e; ((float*)(ws + WS_ROUTE + RT_TOKG))[ent] = tabG[tid]; ((int*)(ws + WS_ROUTE + RT_TOKR))[ent] = rank;
            if (tid < 8) { int c = 0; for (int j = 0; j < 8; ++j) c += wcnt[j * 8 + tid]; ((int*)(ws + CTL_CNT))[blk * 8 + tid] = c; }
            __syncthreads();
        }
    }
}

#undef LN_LOAD
__device__ __forceinline__ void scatter_phase(const Params& p, LAS unsigned char* lds, int G, int bx) {
    unsigned char* ws = p.ws; const int tid = opaque_tid(), lane = tid & 63, wave = __builtin_amdgcn_readfirstlane(tid >> 6);
    LAS int* cnt = (LAS int*)lds;
    LAS int* seg = (LAS int*)(lds + 8192);
    LAS int* base = (LAS int*)(lds + 8192 + 64);
    LAS int* eslot = (LAS int*)(lds + 8192 + 128);
    const int* gcnt = (const int*)(ws + CTL_CNT);
    const bf16_t* xa = (const bf16_t*)(ws + WS_XA); bf16_t* xg = (bf16_t*)p.out;
    int* slot_tok = (int*)(ws + WS_ROUTE + RT_SLOTT); float* slot_gate = (float*)(ws + WS_ROUTE + RT_SLOTG); int* tok_slot = (int*)(ws + WS_ROUTE + RT_TOKS);
    for (int i = tid; i < 2048; i += NTHR) cnt[i] = ld_agent(gcnt + i);
    __syncthreads();
    if (tid < 8) { int tot = 0; for (int w = 0; w < 256; ++w) tot += cnt[w * 8 + tid]; seg[8 + tid] = tot; }
    __syncthreads();
    if (tid == 0) { int s = 0; for (int e = 0; e < 8; ++e) { seg[e] = s; s += seg[8 + e]; } }
    __syncthreads();
    if (bx == 0) {
        int* tab = (int*)(ws + CTL_TAB);
        for (int t = tid; t < TILE_CAP; t += NTHR) { int e = 0, cb = 0, s0 = 0, n = 0, run = 0, segs = 0;
#pragma unroll
            for (int k = 0; k < 8; ++k) { const int nk = seg[8 + k], tk = (nk + 255) >> 8; if (t >= run && t < run + tk) { e = k; cb = run; s0 = segs; n = nk; } run += tk; segs += nk; }
            int v0 = 0, v1 = 0, v2 = 0, v3 = 0;
            if (t < run) { const int st = s0 + 256 * (t - cb), row0 = st < NSLOT - 256 ? st : NSLOT - 256, en = (st + 256 < s0 + n) ? st + 256 : s0 + n; v0 = e; v1 = row0; v2 = st - row0; v3 = en - row0; }
            tab[4 * t] = v0; tab[4 * t + 1] = v1; tab[4 * t + 2] = v2; tab[4 * t + 3] = v3;
            if (t == 0) ((int*)(ws + CTL_META))[0] = run; }
    }
    for (int blk = bx; blk < M / 256; blk += G) {
        if (tid < 8) { int b = seg[tid]; for (int w = 0; w < blk; ++w) b += cnt[w * 8 + tid]; base[tid] = b; }
        __syncthreads();
        { const int ent = blk * 512 + tid; const int e = ((const int*)(ws + WS_ROUTE + RT_TOKE))[ent], rk = ((const int*)(ws + WS_ROUTE + RT_TOKR))[ent];
          const float gt = ((const float*)(ws + WS_ROUTE + RT_TOKG))[ent]; const int slot = base[e] + rk;
          slot_tok[slot] = ent; slot_gate[slot] = gt; tok_slot[ent] = slot; eslot[tid] = slot; }
        __syncthreads();
        __syncthreads();
    }
}

constexpr int AT_P = 72;
constexpr int AT_BLK = 128 * AT_P;
__device__ __forceinline__ void attn_phase(LAS unsigned char* lds, const bf16_t* Qt, const bf16_t* Kt, const bf16_t* Vt, bf16_t* OG, float* LSE, int G, int bx) {
    const int tid = opaque_tid(), lane = tid & 63, wave = __builtin_amdgcn_readfirstlane(tid >> 6);
    LAS bf16_t* Kr = (LAS bf16_t*)lds; LAS bf16_t* Vr = Kr + 3 * AT_BLK;
    const int c = lane & 15, gq = lane >> 4, q4 = c >> 2, p4 = c & 3;
    const int q0 = 16 * wave;
    const float SC = 0.125f * 1.4426950408889634f;
    for (int i = tid; i < 2 * 3 * AT_BLK * 2 / 16; i += NTHR) ((LAS u32x4*)lds)[i] = (u32x4){0u, 0u, 0u, 0u};
    __syncthreads();
#define AT_DECODE(e, g, r, n) int g, r, n; if ((e) <= 16) { g = 0; r = 0; n = (e) == 0 ? 15 : 16 * half + (e) - 1; } else if ((e) <= 32) { g = 1; r = 2 * half + (((e) - 17) >> 3); n = ((e) - 17) & 7; } else { g = 2; r = half + 2 * (((e) - 33) >> 1); n = ((e) - 33) & 1; }
    for (int su = bx; su < 256; su += G) {
        const int b = su >> 4, h = (su >> 1) & 7, half = su & 1;
        const int e0 = half ? 0 : 1;
        u32x4 rk[2], rv[2], rq[2], rqn[2];
        rq[0] = rq[1] = (u32x4){0u, 0u, 0u, 0u};
#define AT_LOAD(e, RQ) do { AT_DECODE(e, g_, r_, n_); const int L_ = 4096 >> (2 * g_); const size_t seg_ = ((size_t)((b * 3 + g_) * 8 + h) * 4096 + (size_t)r_ * L_ + (size_t)n_ * 128) * 64; \
        _Pragma("unroll") for (int i_ = 0; i_ < 2; ++i_) { rk[i_] = *(const u32x4*)(Kt + seg_ + (size_t)(tid + 512 * i_) * 8); rv[i_] = *(const u32x4*)(Vt + seg_ + (size_t)(tid + 512 * i_) * 8); } \
        _Pragma("unroll") for (int ks_ = 0; ks_ < 2; ++ks_) RQ[ks_] = *(const u32x4*)(Qt + seg_ + (size_t)(q0 + c) * 64 + 32 * ks_ + 8 * gq); } while (0)
#define AT_WRITE(slot) do { _Pragma("unroll") for (int i_ = 0; i_ < 2; ++i_) { const int id_ = tid + 512 * i_; \
        *(LAS u32x4*)(Kr + (slot) * AT_BLK + (id_ >> 3) * AT_P + (id_ & 7) * 8) = rk[i_]; *(LAS u32x4*)(Vr + (slot) * AT_BLK + (id_ >> 3) * AT_P + (id_ & 7) * 8) = rv[i_]; } } while (0)
        AT_LOAD(e0, rq);
        __syncthreads();
        AT_WRITE(e0 % 3);
        asm volatile("" : "+v"(rq[0]), "+v"(rq[1]));
        __syncthreads();
        for (int e = e0; e < 49; ++e) {
            if (e + 1 < 49) AT_LOAD(e + 1, rqn);
            if (e > 0) {
                AT_DECODE(e, g, r, n);
                const int cur = e % 3, prv = (e + 2) % 3;
                const int tskip = (n == 0) ? 8 - wave : 0;
                bf16x8 qf[2]; __builtin_memcpy(&qf[0], &rq[0], 16); __builtin_memcpy(&qf[1], &rq[1], 16);
                f32x4 s[9];
#pragma unroll
                for (int t = 0; t < 9; ++t) { s[t] = (f32x4){0.f, 0.f, 0.f, 0.f};
                    if (t >= tskip) { const int kb = q0 + 16 * t; const LAS bf16_t* kp = Kr + ((kb >> 7) ? cur : prv) * AT_BLK + ((kb & 127) + c) * AT_P + 8 * gq;
#pragma unroll
                        for (int ks = 0; ks < 2; ++ks) { const bf16x8 kf = *(const LAS bf16x8*)(kp + 32 * ks); s[t] = __builtin_amdgcn_mfma_f32_16x16x32_bf16(kf, qf[ks], s[t], 0, 0, 0); } } }
#pragma unroll
                for (int jx = 0; jx < 4; ++jx) { if (4 * gq + jx < c) s[0][jx] = -INFINITY; if (4 * gq + jx > c) s[8][jx] = -INFINITY; }
                float mx = -INFINITY;
#pragma unroll
                for (int t = 0; t < 9; ++t) { if (t < tskip) s[t] = (f32x4){-INFINITY, -INFINITY, -INFINITY, -INFINITY};
#pragma unroll
                    for (int jx = 0; jx < 4; ++jx) mx = fmaxf(mx, s[t][jx]); }
                mx = fmaxf(mx, shx(mx, 16, lane)); mx = fmaxf(mx, shx(mx, 32, lane));
                const float mxs = mx * SC; float ls = 0.f;
#pragma unroll
                for (int t = 0; t < 9; ++t)
#pragma unroll
                    for (int jx = 0; jx < 4; ++jx) { const float pv = __builtin_amdgcn_exp2f(s[t][jx] * SC - mxs); s[t][jx] = pv; ls += pv; }
                ls += shx(ls, 16, lane); ls += shx(ls, 32, lane);
                f32x4 o[4];
#pragma unroll
                for (int dt = 0; dt < 4; ++dt) o[dt] = (f32x4){0.f, 0.f, 0.f, 0.f};
#pragma unroll
                for (int s5 = 0; s5 < 4; ++s5) {
                    if (2 * s5 + 1 >= tskip) {
                        const u32x4 pw = pack8(s[2 * s5], s[2 * s5 + 1]); bf16x8 pf; __builtin_memcpy(&pf, &pw, 16);
                        const int kb0 = q0 + 32 * s5, kb1 = kb0 + 16;
                        const LAS bf16_t* vp0 = Vr + ((kb0 >> 7) ? cur : prv) * AT_BLK + ((kb0 & 127) + 4 * gq + q4) * AT_P + 4 * p4;
                        const LAS bf16_t* vp1 = Vr + ((kb1 >> 7) ? cur : prv) * AT_BLK + ((kb1 & 127) + 4 * gq + q4) * AT_P + 4 * p4;
#pragma unroll
                        for (int dt = 0; dt < 4; ++dt) {
                            const bf16x4 v0 = __builtin_amdgcn_ds_read_tr16_b64_v4i16((LAS bf16x4*)(vp0 + 16 * dt));
                            const bf16x4 v1 = __builtin_amdgcn_ds_read_tr16_b64_v4i16((LAS bf16x4*)(vp1 + 16 * dt));
                            const bf16x8 vf = (bf16x8){v0[0], v0[1], v0[2], v0[3], v1[0], v1[1], v1[2], v1[3]};
                            o[dt] = __builtin_amdgcn_mfma_f32_16x16x32_bf16(vf, pf, o[dt], 0, 0, 0); } } }
                {
                    u32x2 pw; pw.x = cvt_pk_bf16(s[8][0], s[8][1]); pw.y = cvt_pk_bf16(s[8][2], s[8][3]); bf16x4 pf4; __builtin_memcpy(&pf4, &pw, 8);
                    const LAS bf16_t* vp = Vr + cur * AT_BLK + (q0 + 4 * gq + q4) * AT_P + 4 * p4;
#pragma unroll
                    for (int dt = 0; dt < 4; ++dt) { const bf16x4 v0 = __builtin_amdgcn_ds_read_tr16_b64_v4i16((LAS bf16x4*)(vp + 16 * dt)); o[dt] = __builtin_amdgcn_mfma_f32_16x16x16bf16_1k(v0, pf4, o[dt], 0, 0, 0); } }
                const float inv = 1.0f / ls;
                const int token = b * 4096 + (((n * 128 + q0 + c) << (2 * g)) + r);
                bf16_t* od = OG + ((size_t)token * 3 + g) * ATTW + h * 64 + 4 * gq;
#pragma unroll
                for (int dt = 0; dt < 4; ++dt) { u32x2 w; w.x = cvt_pk_bf16(o[dt][0] * inv, o[dt][1] * inv); w.y = cvt_pk_bf16(o[dt][2] * inv, o[dt][3] * inv); *(u32x2*)(od + 16 * dt) = w; }
                if (gq == 0) LSE[((size_t)token * 3 + g) * 8 + h] = (mxs + __builtin_amdgcn_logf(ls)) * 0.6931471805599453f;
            }
            if (e + 1 < 49) AT_WRITE((e + 1) % 3);
            __syncthreads();
            rq[0] = rqn[0]; rq[1] = rqn[1];
        }
#undef AT_LOAD
#undef AT_WRITE
    }
#undef AT_DECODE
}
__device__ __forceinline__ void combine_phase(const bf16_t* OG, const float* LSE, bf16_t* O, int G, int bx) {
    const int tid = opaque_tid();
    for (size_t it = (size_t)bx * NTHR + tid; it < (size_t)M * 64; it += (size_t)G * NTHR) {
        const size_t token = it >> 6; const int h = (int)(it >> 3) & 7, ch = (int)it & 7;
        const float l0 = LSE[(token * 3 + 0) * 8 + h], l1 = LSE[(token * 3 + 1) * 8 + h], l2 = LSE[(token * 3 + 2) * 8 + h];
        const float mx = fmaxf(l0, fmaxf(l1, l2)); float w0 = __expf(l0 - mx), w1 = __expf(l1 - mx), w2 = __expf(l2 - mx); const float inv = 1.0f / (w0 + w1 + w2); w0 *= inv; w1 *= inv; w2 *= inv;
        const u32x4 a = *(const u32x4*)(OG + (token * 3 + 0) * ATTW + h * 64 + ch * 8), b = *(const u32x4*)(OG + (token * 3 + 1) * ATTW + h * 64 + ch * 8), c = *(const u32x4*)(OG + (token * 3 + 2) * ATTW + h * 64 + ch * 8);
        const unsigned aa[4] = {a.x, a.y, a.z, a.w}, bb[4] = {b.x, b.y, b.z, b.w}, cc[4] = {c.x, c.y, c.z, c.w}; unsigned o[4];
#pragma unroll
        for (int j = 0; j < 4; ++j) o[j] = cvt_pk_bf16(w0 * bf_lo(aa[j]) + w1 * bf_lo(bb[j]) + w2 * bf_lo(cc[j]), w0 * bf_hi(aa[j]) + w1 * bf_hi(bb[j]) + w2 * bf_hi(cc[j]));
        *(u32x4*)(O + token * ATTW + h * 64 + ch * 8) = (u32x4){o[0], o[1], o[2], o[3]};
    }
}

__global__ void __launch_bounds__(NTHR, 2) mk_fwd(Params p) {
    extern __shared__ __attribute__((aligned(16))) unsigned char lds_raw[];
    LAS unsigned char* lds = (LAS unsigned char*)lds_raw;
    constexpr int G = NWG; const int bx = blockIdx.x;
    unsigned char* ws = p.ws;
    volatile LAS unsigned* MISC = (volatile LAS unsigned*)(lds + LDS_MISC);
    if (threadIdx.x < 4) MISC[threadIdx.x] = 0u;
    __syncthreads();
    XcdBarrier bar = xcd_barrier_post((unsigned*)(ws + WS_CTL) + CW_BAR, MISC);
    int pc = 0;
#define PH_IF if (pc >= p.lo && pc < p.hi)
#define PH_END do { if (pc >= p.lo && pc + 1 < p.hi) xcd_barrier(bar); ++pc; } while (0)
    bf16_t* xa = (bf16_t*)(ws + WS_XA);
    unsigned char* big = ws + WS_BIG;
    const float* ln_g = p.in[IN_LNG]; const float* ln_b = p.in[IN_LNB];

    PH_IF { p0_phase(p, lds, G, opq_i(bx)); } PH_END;

    for (int pr = 0; pr < 2; ++pr) {
        for (int q = 0; q < 2; ++q) {
            const int l = 2 * pr + q;
            bf16_t* ysrc;
            if (pr == 0) {
                PH_IF { Gemm g{xa, (const bf16_t*)(ws + WS_WIN + l * SZ_WIN), D}; DenseOrder S; S.init(M, 3 * D, G, opq_i(bx), 0);
                        EpiCU E{(bf16_t*)(big + BG_CU), (bf16_t*)(big + BG_GB)};
                        if (l == 0) { TrMoeHook X{p.in[IN_MG], (long long)((const char*)p.in[IN_MU] - (const char*)p.in[IN_MG]), p.in[IN_MD], (bf16_t*)(ws + WS_WM), (bf16_t*)(ws + WS_WM + SZ_WMGU), opq_i(bx) * 8 + __builtin_amdgcn_readfirstlane(opaque_tid() >> 6)}; gemm_phase(lds, g, S, E, X); }
                        else gemm_phase(lds, g, S, E); } PH_END;
                PH_IF { conv_phase((const bf16_t*)(big + BG_CU), (const bf16_t*)(big + BG_GB), (bf16_t*)(big + BG_G), p.in[IN_ACONV] + (size_t)l * 3 * D, G, opq_i(bx)); } PH_END;
                ysrc = (bf16_t*)p.out;
            } else {
                PH_IF { Gemm g{xa, (const bf16_t*)(ws + (q == 0 ? WS_WQKV2 : WS_WQ3)), D}; DenseOrder S; S.init(M, q == 0 ? NQ + NKV : NQ, G, opq_i(bx), 0);
                        EpiQKV E{(bf16_t*)((unsigned char*)p.out + DO_Q), (bf16_t*)(big + BG_K)};
                        if (q == 0) { TrMoeHook X{p.in[IN_MG] + (size_t)NE * D * DEX, (long long)((const char*)p.in[IN_MU] - (const char*)p.in[IN_MG]), p.in[IN_MD] + (size_t)NE * DEX * D, (bf16_t*)(ws + WS_WM), (bf16_t*)(ws + WS_WM + SZ_WMGU), opq_i(bx) * 8 + __builtin_amdgcn_readfirstlane(opaque_tid() >> 6)}; gemm_phase(lds, g, S, E, X); }
                        else gemm_phase(lds, g, S, E); } PH_END;
                PH_IF { attn_phase(lds, (const bf16_t*)((unsigned char*)p.out + DO_Q), (const bf16_t*)(big + BG_K), (const bf16_t*)(big + BG_V), (bf16_t*)(big + BG_OG), (float*)(big + BG_LSE), G, opq_i(bx)); } PH_END;
                PH_IF { combine_phase((const bf16_t*)(big + BG_OG), (const float*)(big + BG_LSE), (bf16_t*)((unsigned char*)p.out + DO_O), G, opq_i(bx)); } PH_END;
                ysrc = (bf16_t*)(big + BG_YATT);
            }
            PH_IF { Gemm g; if (pr == 0) g = Gemm{(const bf16_t*)(big + BG_G), (const bf16_t*)(ws + WS_WOUT + l * SZ_WOUT), D}; else g = Gemm{(const bf16_t*)((unsigned char*)p.out + DO_O), (const bf16_t*)(ws + WS_WO + q * SZ_WO), ATTW};
                    DenseOrder S; S.init(M, D, G, opq_i(bx), 0); EpiResid E{ysrc, xa}; gemm_phase(lds, g, S, E); } PH_END;
            if (q == 0) { PH_IF { ln_phase<0>(p, lds, ysrc, ln_g + (size_t)(l * 2) * D, ln_b + (size_t)(l * 2) * D, nullptr, G, opq_i(bx)); } PH_END; }
            else        { PH_IF { ln_phase<1>(p, lds, ysrc, ln_g + (size_t)(l * 2) * D, ln_b + (size_t)(l * 2) * D, p.in[IN_MR] + (size_t)pr * D * NE, G, opq_i(bx)); } PH_END; }
            if (q == 0) {
                for (int hf = 0; hf < 2; ++hf) {
                    PH_IF { Gemm g{xa + (size_t)hf * (M / 2) * D, (const bf16_t*)(ws + WS_WGU + pr * SZ_WGU), D}; DenseOrder S; S.init(M / 2, 2 * DFF, G, opq_i(bx), 0);
                            EpiSwiGLU E{(bf16_t*)(big + BG_HH), DFF}; gemm_phase(lds, g, S, E); } PH_END;
                    PH_IF { Gemm g{(const bf16_t*)(big + BG_HH), (const bf16_t*)(ws + WS_WDN + pr * SZ_WDN), DFF}; DenseOrder S; S.init(M / 2, D, G, opq_i(bx), hf * (M / 2));
                            EpiResid E{(bf16_t*)p.out, xa}; gemm_phase(lds, g, S, E); } PH_END;
                }
                PH_IF { ln_phase<0>(p, lds, (const bf16_t*)p.out, ln_g + (size_t)(l * 2 + 1) * D, ln_b + (size_t)(l * 2 + 1) * D, nullptr, G, opq_i(bx)); } PH_END;
            } else {
                PH_IF { scatter_phase(p, lds, G, opq_i(bx)); } PH_END;
                for (int cch = 0; cch < NCHUNK; ++cch) {
                    PH_IF { const int T = __builtin_amdgcn_readfirstlane(ld_agent((const int*)(ws + CTL_META))); int px = T - NCHUNK * CH_TILES; px = px < 0 ? 0 : (px > CH_LAST - CH_TILES ? CH_LAST - CH_TILES : px);
                            const int t0 = cch <= 1 ? cch * CH_TILES : cch * CH_TILES + px; int ntab = T - t0; { const int cap = cch <= 1 ? CH_TILES + px : CH_TILES; ntab = ntab < 0 ? 0 : (ntab > cap ? cap : ntab); }
                            LAS int* ltab = (LAS int*)(lds + LDS_TAB);
                            const int r0 = moe_tab_to_lds((const int*)(ws + CTL_TAB), t0, ntab, ltab);
                            int skip = 0, xt = 1 << 30, row0x = 0, H = 0, row0c = r0;
                            if (cch == 0 && px > 0 && ntab == CH_TILES + px) { xt = CH_TILES; row0x = __builtin_amdgcn_readfirstlane(ltab[4 * CH_TILES + 1]) - XROW; }
                            if (cch == 1 && px > 0 && ntab == CH_TILES + px) {
                                Gemm gx{(const bf16_t*)(big + BG_HC), (const bf16_t*)(ws + WS_WM + SZ_WMGU), DEX}; MoeOrder<false> SX{nullptr, (const LAS int*)ltab, px, D / BM, G, opq_i(bx), r0 - XROW, D, 1, 1 << 30, 0, 0};
                                EpiMoeDown EX{(bf16_t*)(big + BG_Y2), (const int*)(ws + WS_ROUTE + RT_SLOTT), (const float*)(ws + WS_ROUTE + RT_SLOTG)}; gemm_phase(lds, gx, SX, EX);
                                skip = px; row0c = __builtin_amdgcn_readfirstlane(ltab[4 * px + 1]); H = 4 * px; }
                            Gemm g{xa, (const bf16_t*)(ws + WS_WM), D}; MoeOrder<true> S{(const int*)(ws + WS_ROUTE + RT_SLOTT), (const LAS int*)(ltab + 4 * skip), ntab - skip, 2 * DEX / BM, G, opq_i(bx), row0c, 2 * DEX, 0, xt, row0x, H};
                            EpiSwiGLU E{(bf16_t*)(big + BG_HC), DEX}; gemm_phase(lds, g, S, E); } PH_END;
                    PH_IF { const int T = __builtin_amdgcn_readfirstlane(ld_agent((const int*)(ws + CTL_META))); int px = T - NCHUNK * CH_TILES; px = px < 0 ? 0 : (px > CH_LAST - CH_TILES ? CH_LAST - CH_TILES : px);
                            const int t0 = cch == 0 ? 0 : cch * CH_TILES + px; int nt = T - t0; nt = nt < 0 ? 0 : (nt > CH_TILES ? CH_TILES : nt);
                            const int row0c = moe_tab_to_lds((const int*)(ws + CTL_TAB), t0, nt, (LAS int*)(lds + LDS_TAB));
                            Gemm g{(const bf16_t*)(big + BG_HC), (const bf16_t*)(ws + WS_WM + SZ_WMGU), DEX}; MoeOrder<false> S{nullptr, (const LAS int*)(lds + LDS_TAB), nt, D / BM, G, opq_i(bx), row0c, D, 1, 1 << 30, 0, 0};
                            EpiMoeDown E{(bf16_t*)(big + BG_Y2), (const int*)(ws + WS_ROUTE + RT_SLOTT), (const float*)(ws + WS_ROUTE + RT_SLOTG)}; gemm_phase(lds, g, S, E); } PH_END;
                }
                if (l == 1) { PH_IF { ln_phase<2>(p, lds, nullptr, ln_g + (size_t)(l * 2 + 1) * D, ln_b + (size_t)(l * 2 + 1) * D, nullptr, G, opq_i(bx)); } PH_END; }
                else        { PH_IF { ln_phase<3>(p, lds, nullptr, ln_g + (size_t)(l * 2 + 1) * D, ln_b + (size_t)(l * 2 + 1) * D, nullptr, G, opq_i(bx)); } PH_END; }
            }
        }
    }
#undef PH_IF
#undef PH_END
}
constexpr int NPHASE = 49;

#if MK_DEBUG
enum { K_P0 = 0, K_GIN, K_CONV, K_RESA, K_LN0, K_LN1, K_GU, K_DN, K_LNF, K_SCAT, K_MGU, K_MDN, K_LNM, K_QKV, K_ATT, K_COMB, K_RESB };
__device__ __forceinline__ float bf2f(bf16_t v) { return __uint_as_float((unsigned)v << 16); }
__device__ float dot_a(const bf16_t* a, const float* W, int ldw, int K, float& nrm) { float s = 0.f, q = 0.f; for (int k = 0; k < K; ++k) { const float t = bf2f(a[k]) * W[(size_t)k * ldw]; s += t; q += t * t; } nrm = sqrtf(q); return s; }
__device__ bool closef(float got, float ref, float nrm) { return fabsf(got - ref) <= 0.02f * fabsf(ref) + 0.02f * nrm + 2e-3f && got == got; }
__device__ unsigned hsh(unsigned x) { x ^= x >> 16; x *= 0x7feb352du; x ^= x >> 15; x *= 0x846ca68bu; x ^= x >> 16; return x; }
__device__ int pick_row(unsigned sid, int nrows) { switch (sid) { case 0: return 0; case 1: return 1; case 2: return 255; case 3: return 256; case 4: return 257; case 5: return nrows - 1; case 6: return nrows - 256; case 7: return nrows / 2 + 127; default: break; } return (int)(hsh(sid * 2u + 1u) % (unsigned)nrows); }
__global__ void mk_check(Params p, int kind, int l, int a0, int pc) {
    const unsigned sid = blockIdx.x * blockDim.x + threadIdx.x; unsigned char* ws = p.ws; unsigned char* big = ws + WS_BIG;
    unsigned* dbg = (unsigned*)(ws + WS_CTL) + CW_DBG; const bf16_t* xa = (const bf16_t*)(ws + WS_XA);
    bool ok = true; float n1, n2;
    if (kind == K_GIN) { const int m = pick_row(sid, M), c = hsh(sid) % D; const float* W = p.in[IN_AWIN] + (size_t)l * D * 3 * D;
        const float rb = dot_a(xa + (size_t)m * D, W + c, 3 * D, D, n1); ok = closef(bf2f(((const bf16_t*)(big + BG_GB))[(size_t)m * D + c]), rb, n1);
        const float rc = dot_a(xa + (size_t)m * D, W + D + c, 3 * D, D, n1), ru = dot_a(xa + (size_t)m * D, W + 2 * D + c, 3 * D, D, n2);
        ok = ok && closef(bf2f(((const bf16_t*)(big + BG_CU))[(size_t)m * D + c]), rc * ru, fabsf(rc) * n2 + fabsf(ru) * n1);
    } else if (kind == K_CONV) { const int m = pick_row(sid, M), c = hsh(sid) % D, s = m & (SEQ - 1); const bf16_t* CU = (const bf16_t*)(big + BG_CU); const float* cw = p.in[IN_ACONV] + (size_t)l * 3 * D;
        float cv = cw[2 * D + c] * bf2f(CU[(size_t)m * D + c]); if (s >= 1) cv += cw[D + c] * bf2f(CU[(size_t)(m - 1) * D + c]); if (s >= 2) cv += cw[c] * bf2f(CU[(size_t)(m - 2) * D + c]);
        const float ref = bf2f(((const bf16_t*)(big + BG_GB))[(size_t)m * D + c]) * cv; ok = closef(bf2f(((const bf16_t*)(big + BG_G))[(size_t)m * D + c]), ref, 0.f);
    } else if (kind == K_RESA) { const int m = pick_row(sid, M), c = hsh(sid) % D; const float ref = ALPHA * bf2f(xa[(size_t)m * D + c]) + dot_a((const bf16_t*)(big + BG_G) + (size_t)m * D, p.in[IN_AWOUT] + (size_t)l * D * D + c, D, D, n1);
        ok = closef(bf2f(((const bf16_t*)p.out)[(size_t)m * D + c]), ref, n1);
    } else if (kind == K_RESB) { const int m = pick_row(sid, M), c = hsh(sid) % D; const float ref = ALPHA * bf2f(xa[(size_t)m * D + c]) + dot_a((const bf16_t*)((unsigned char*)p.out + DO_O) + (size_t)m * ATTW, p.in[IN_BWO] + (size_t)(l - 2) * ATTW * D + c, D, ATTW, n1);
        ok = closef(bf2f(((const bf16_t*)(big + BG_YATT))[(size_t)m * D + c]), ref, n1);
    } else if (kind == K_LN0 || kind == K_LN1 || kind == K_LNF) { const int m = pick_row(sid, M), c = hsh(sid) % D; const bf16_t* Yb = (kind == K_LNF || l < 2) ? (const bf16_t*)p.out : (const bf16_t*)(big + BG_YATT); const int which = (kind == K_LNF) ? 1 : 0;
        const float* gm = p.in[IN_LNG] + (size_t)(l * 2 + which) * D; const float* bt = p.in[IN_LNB] + (size_t)(l * 2 + which) * D;
        float mu = 0.f; for (int k = 0; k < D; ++k) mu += bf2f(Yb[(size_t)m * D + k]); mu /= D; float var = 0.f; for (int k = 0; k < D; ++k) { const float d = bf2f(Yb[(size_t)m * D + k]) - mu; var += d * d; } var /= D; const float rs = 1.0f / sqrtf(var + LN_EPS);
        ok = closef(bf2f(xa[(size_t)m * D + c]), (bf2f(Yb[(size_t)m * D + c]) - mu) * rs * gm[c] + bt[c], 0.f);
        if (kind == K_LN1) { const float* wr = p.in[IN_MR] + (size_t)(l / 2) * D * NE; int b1 = -1, b2 = -1; float v1 = -1e30f, v2 = -1e30f, v3 = -1e30f;
            for (int e = 0; e < 8; ++e) { float a = 0.f; for (int k = 0; k < D; ++k) a += ((bf2f(Yb[(size_t)m * D + k]) - mu) * rs * gm[k] + bt[k]) * wr[k * NE + e];
                if (a > v1) { v3 = v2; v2 = v1; b2 = b1; v1 = a; b1 = e; } else if (a > v2) { v3 = v2; v2 = a; b2 = e; } else if (a > v3) v3 = a; }
            const int e1 = ((const int*)(ws + WS_ROUTE + RT_TOKE))[m * 2], e2 = ((const int*)(ws + WS_ROUTE + RT_TOKE))[m * 2 + 1]; const float g1 = ((const float*)(ws + WS_ROUTE + RT_TOKG))[m * 2], g2 = ((const float*)(ws + WS_ROUTE + RT_TOKG))[m * 2 + 1];
            const bool tie = (v1 - v2 < 1e-3f) || (v2 - v3 < 1e-3f); const float r1 = 1.0f / (1.0f + expf(v2 - v1));
            if (!tie) ok = ok && e1 == b1 && e2 == b2 && fabsf(g1 - r1) < 2e-3f && fabsf(g1 + g2 - 1.0f) < 1e-4f; }
    } else if (kind == K_GU) { const int mr = pick_row(sid, M / 2), f = hsh(sid) % DFF, m = a0 * (M / 2) + mr; const int i = l / 2;
        const float rg = dot_a(xa + (size_t)m * D, p.in[IN_FG] + (size_t)i * D * DFF + f, DFF, D, n1), ru = dot_a(xa + (size_t)m * D, p.in[IN_FU] + (size_t)i * D * DFF + f, DFF, D, n2);
        const float sg = rg / (1.0f + expf(-rg)); ok = closef(bf2f(((const bf16_t*)(big + BG_HH))[(size_t)mr * DFF + f]), sg * ru, fabsf(sg) * n2 + fabsf(ru) * n1);
    } else if (kind == K_DN) { const int mr = pick_row(sid, M / 2), c = hsh(sid) % D, m = a0 * (M / 2) + mr; const int i = l / 2;
        const float ref = ALPHA * bf2f(xa[(size_t)m * D + c]) + dot_a((const bf16_t*)(big + BG_HH) + (size_t)mr * DFF, p.in[IN_FD] + (size_t)i * DFF * D + c, D, DFF, n1); ok = closef(bf2f(((const bf16_t*)p.out)[(size_t)m * D + c]), ref, n1);
    } else if (kind == K_SCAT) { const int* tok_slot = (const int*)(ws + WS_ROUTE + RT_TOKS); const int* slot_tok = (const int*)(ws + WS_ROUTE + RT_SLOTT); const int* tok_e = (const int*)(ws + WS_ROUTE + RT_TOKE); const int* gcnt = (const int*)(ws + CTL_CNT);
        for (int ent = sid; ent < NSLOT; ent += gridDim.x * blockDim.x) { const int slot = tok_slot[ent]; if (slot < 0 || slot >= NSLOT || slot_tok[slot] != ent) ok = false; }
        const int ent = hsh(sid) % NSLOT, slot = tok_slot[ent], e = tok_e[ent]; int s0 = 0, n = 0; for (int x = 0; x < 8; ++x) { int t = 0; for (int w = 0; w < 256; ++w) t += gcnt[w * 8 + x]; if (x < e) s0 += t; if (x == e) n = t; }
        if (slot >= 0 && slot < NSLOT) { if (slot < s0 || slot >= s0 + n) ok = false; const int c = hsh(sid + 77u) % D; if (((const bf16_t*)p.out)[(size_t)slot * D + c] != xa[(size_t)(ent >> 1) * D + c]) ok = false; }
        if (sid == 0) { const int T = ((const int*)(ws + CTL_META))[0]; if (T < 512 || T > 520) ok = false; }
    } else if (kind == K_MGU || kind == K_MDN) { const int* tab = (const int*)(ws + CTL_TAB); const int T = ((const int*)(ws + CTL_META))[0]; const int t0 = a0 * CH_TILES; int nt = T - t0; const int cap = (a0 == NCHUNK - 1) ? CH_LAST : CH_TILES; nt = nt < 0 ? 0 : (nt > cap ? cap : nt);
        if (nt > 0) { const int t = t0 + hsh(sid) % nt, e = tab[4 * t], row0 = tab[4 * t + 1], lo = tab[4 * t + 2], hi = tab[4 * t + 3], row0c = tab[4 * t0 + 1];
            const int r = (sid & 3) == 0 ? lo : ((sid & 3) == 1 ? hi - 1 : lo + hsh(sid + 5u) % (hi - lo)); const int slot = row0 + r; const int i = l / 2;
            const int ent = ((const int*)(ws + WS_ROUTE + RT_SLOTT))[slot]; if (((const int*)(ws + WS_ROUTE + RT_TOKE))[ent] != e) ok = false;
            const bf16_t* hrow = (const bf16_t*)(big + BG_HC) + (size_t)(slot - row0c) * DEX;
            if (kind == K_MGU) { const int f = hsh(sid + 9u) % DEX; const bf16_t* xr = (const bf16_t*)p.out + (size_t)slot * D; const size_t wo = ((size_t)i * NE + e) * D * DEX + f;
                const float rg = dot_a(xr, p.in[IN_MG] + wo, DEX, D, n1), ru = dot_a(xr, p.in[IN_MU] + wo, DEX, D, n2); const float sg = rg / (1.0f + expf(-rg));
                ok = ok && closef(bf2f(hrow[f]), sg * ru, fabsf(sg) * n2 + fabsf(ru) * n1);
            } else { const int c = hsh(sid + 9u) % D; const float gt = ((const float*)(ws + WS_ROUTE + RT_SLOTG))[slot];
                const float ref = gt * dot_a(hrow, p.in[IN_MD] + ((size_t)i * NE + e) * DEX * D + c, D, DEX, n1);
                ok = ok && closef(bf2f(((const bf16_t*)(big + BG_Y2))[((size_t)(ent & 1) * M + (ent >> 1)) * D + c]), ref, gt * n1); } }
    } else if (kind == K_QKV) { const int m = pick_row(sid, M), ncol = (l == 2) ? NQ + NKV : NQ, c = hsh(sid) % ncol; float ref; bf16_t got;
        if (c < NQ) { ref = dot_a(xa + (size_t)m * D, p.in[IN_BWQ] + (size_t)(l - 2) * D * NQ + c, NQ, D, n1); got = ((const bf16_t*)((unsigned char*)p.out + DO_Q))[resid_off(m, c >> 9, (c >> 6) & 7, c & 63)]; }
        else { const int c2 = c - NQ; ref = dot_a(xa + (size_t)m * D, p.in[IN_KVW] + c2, NKV, D, n1); got = ((const bf16_t*)(big + (((c2 >> 9) & 1) ? BG_V : BG_K)))[resid_off(m, c2 >> 10, (c2 >> 6) & 7, c2 & 63)]; }
        ok = closef(bf2f(got), ref, n1);
    } else if (kind == K_ATT) { const int m = pick_row(sid, M), g = hsh(sid) % 3, h = hsh(sid + 3u) % 8, d = 1 << (2 * g), b = m >> 12, s = m & 4095; const bf16_t* Q = (const bf16_t*)((unsigned char*)p.out + DO_Q); const bf16_t* K = (const bf16_t*)(big + BG_K); const bf16_t* V = (const bf16_t*)(big + BG_V);
        float mx = -1e30f; const int ev = hsh(sid + 11u) % 64; float den = 0.f, o = 0.f;
        for (int pass = 0; pass < 2; ++pass) for (int j = 0; j <= 128; ++j) { const int sk = s - j * d; if (sk < 0) break; float a = 0.f; for (int e = 0; e < 64; ++e) a += bf2f(Q[resid_off(m, g, h, e)]) * bf2f(K[resid_off(b * 4096 + sk, g, h, e)]); a *= 0.125f;
            if (pass == 0) mx = fmaxf(mx, a); else { const float pe = expf(a - mx); den += pe; o += pe * bf2f(V[resid_off(b * 4096 + sk, g, h, ev)]); } }
        o /= den; const int e = ev;
        ok = closef(bf2f(((const bf16_t*)(big + BG_OG))[((size_t)m * 3 + g) * ATTW + h * 64 + e]), o, 0.02f) && closef(((const float*)(big + BG_LSE))[((size_t)m * 3 + g) * 8 + h], mx + logf(den), 0.05f);
    } else if (kind == K_COMB) { const int m = pick_row(sid, M), h = hsh(sid) % 8, e = hsh(sid + 3u) % 64; const float* L = (const float*)(big + BG_LSE) + (size_t)m * 24 + h; const float mx = fmaxf(L[0], fmaxf(L[8], L[16]));
        const float w0 = expf(L[0] - mx), w1 = expf(L[8] - mx), w2 = expf(L[16] - mx); const bf16_t* og = (const bf16_t*)(big + BG_OG) + (size_t)m * 3 * ATTW + h * 64 + e;
        ok = closef(bf2f(((const bf16_t*)((unsigned char*)p.out + DO_O))[(size_t)m * ATTW + h * 64 + e]), (w0 * bf2f(og[0]) + w1 * bf2f(og[ATTW]) + w2 * bf2f(og[2 * ATTW])) / (w0 + w1 + w2), 0.02f);
    }
    if (!ok) atomicAdd(&dbg[1 + pc], 1u);
    if (sid == 0 && ((const unsigned*)(ws + WS_CTL))[CW_BAR + XB_TMO] != 0u) atomicAdd(&dbg[1 + 98], 1u);
}
__global__ void mk_report(float* out, const unsigned* dbg) {
    int code = 0; for (int pc = 0; pc < 99 && code == 0; ++pc) if (dbg[1 + pc] > (pc == 98 ? 0u : 12u)) code = pc + 1;
    if (code == 0) return;
    const float V = sqrtf(100.0f * (float)code);
    for (size_t i = (size_t)blockIdx.x * blockDim.x + threadIdx.x; i < (size_t)M * D; i += (size_t)gridDim.x * blockDim.x) out[i] = V;
}
#endif
}

extern "C" void kernel_launch(void* const* d_in, const int* in_sizes, int n_in, void* d_out, int out_size, void* d_ws, size_t ws_size, hipStream_t stream) {
    using namespace mk;
    static int grid = 0;
    if (grid == 0) {
        if (n_in != 16 || in_sizes[0] != M * D || out_size != M * D || ws_size < WS_NEED) { fprintf(stderr, "kernel_launch: unexpected shapes (n_in %d, in0 %d, out %d, ws %zu, need %zu)\n", n_in, n_in > 0 ? in_sizes[0] : -1, out_size, ws_size, (size_t)WS_NEED); grid = -1; return; }
        int dev = 0, cus = 0, per_cu = 0;
        if (hipGetDevice(&dev) != hipSuccess || hipDeviceGetAttribute(&cus, hipDeviceAttributeMultiprocessorCount, dev) != hipSuccess) { grid = -1; return; }
        if (hipFuncSetAttribute((const void*)mk_fwd, hipFuncAttributeMaxDynamicSharedMemorySize, LDS_BYTES) != hipSuccess) { fprintf(stderr, "kernel_launch: hipFuncSetAttribute failed\n"); grid = -1; return; }
        if (hipOccupancyMaxActiveBlocksPerMultiprocessor(&per_cu, (const void*)mk_fwd, NTHR, LDS_BYTES) != hipSuccess || per_cu < 1) fprintf(stderr, "kernel_launch: occupancy query reports %d\n", per_cu);
        (void)hipGetLastError();
        if (cus != NWG) { fprintf(stderr, "kernel_launch: built for %d CUs, device has %d\n", NWG, cus); grid = -1; return; }
        grid = NWG;
    }
    if (grid < 0) return;
    (void)hipMemsetAsync((char*)d_ws + WS_CTL, 0, CTL_ZERO_BYTES, stream);
    Params p{};
    for (int i = 0; i < 16; ++i) p.in[i] = (const float*)d_in[i];
    p.out = (float*)d_out; p.ws = (unsigned char*)d_ws; p.lo = 0; p.hi = NPHASE;
#if !MK_DEBUG
    hipLaunchKernelGGL(mk_fwd, dim3(grid), dim3(NTHR), LDS_BYTES, stream, p);
#else
    int pc = 0;
    auto run = [&](int kind, int l, int a0) { p.lo = pc; p.hi = pc + 1; hipLaunchKernelGGL(mk_fwd, dim3(grid), dim3(NTHR), LDS_BYTES, stream, p);
        if (kind != K_P0 && kind != K_LNM) hipLaunchKernelGGL(mk_check, dim3(4), dim3(256), 0, stream, p, kind, l, a0, pc); ++pc; };
    run(K_P0, 0, 0);
    for (int pr = 0; pr < 2; ++pr) for (int q = 0; q < 2; ++q) { const int l = 2 * pr + q;
        if (pr == 0) { run(K_GIN, l, 0); run(K_CONV, l, 0); run(K_RESA, l, 0); } else { run(K_QKV, l, 0); run(K_ATT, l, 0); run(K_COMB, l, 0); run(K_RESB, l, 0); }
        run(q == 0 ? K_LN0 : K_LN1, l, 0);
        if (q == 0) { for (int hf = 0; hf < 2; ++hf) { run(K_GU, l, hf); run(K_DN, l, hf); } run(K_LNF, l, 0); }
        else { run(K_SCAT, l, 0); for (int c = 0; c < NCHUNK; ++c) { run(K_MGU, l, c); run(K_MDN, l, c); } run(K_LNM, l, 0); } }
    if (pc != NPHASE) fprintf(stderr, "kernel_launch: debug phase enumeration mismatch %d\n", pc);
    hipLaunchKernelGGL(mk_report, dim3(1024), dim3(256), 0, stream, (float*)d_out, (const unsigned*)((char*)d_ws + WS_CTL) + CW_DBG);
#endif
}
```
